# Optimizing an MI355X kernel written in HIP

```python
import math
import jax, jax.numpy as jnp
from jax import lax
import numpy as np

D_MODEL = 2048
BATCH = 8
SEQ = 2048
DEPTH = 2

D_MIX = D_MODEL
D_ATTN = D_MIX // 2
D_SSM = D_MIX - D_ATTN
QK_DIM = 64
V_DIM = 2 * QK_DIM
N_HEADS = D_ATTN // V_DIM
D_QK = N_HEADS * 2 * QK_DIM
ROT_DIM = QK_DIM // 4
ROPE_THETA = 500000.0
Q_BLOCK = 128
SSM_GROUP = 16
N_GROUPS = D_SSM // SSM_GROUP
STATE = 64
DT_MIN = 1e-3
DT_MAX = 1e-1
D_IN = 2 * D_QK + 2 * D_ATTN + 2 * D_SSM
EPS = 1e-6

kernel_name = "hybrid_diffattn_s5_adaln_encoder"


def rmsnorm(x, g):
    xf = x.astype(jnp.float32)
    y = xf * lax.rsqrt(jnp.mean(xf * xf, axis=-1, keepdims=True) + EPS)
    return (y * g.astype(jnp.float32)).astype(x.dtype)


def partial_rotary(t, pos):
    half = ROT_DIM // 2
    inv = ROPE_THETA ** (-(jnp.arange(half, dtype=jnp.float32) * 2.0 / ROT_DIM))
    ang = pos.astype(jnp.float32)[:, :, None] * inv
    cos = jnp.cos(ang)[:, :, None, None, :]
    sin = jnp.sin(ang)[:, :, None, None, :]
    tf = t.astype(jnp.float32)
    t1, t2, tp = tf[..., :half], tf[..., half:ROT_DIM], tf[..., ROT_DIM:]
    out = jnp.concatenate([t1 * cos - t2 * sin, t2 * cos + t1 * sin, tp], axis=-1)
    return out.astype(t.dtype)


def diff_attention(q, k, v, lam):
    b, l, h, _, dk = q.shape
    nblk = l // Q_BLOCK
    qb = (q * (dk ** -0.5)).transpose(1, 0, 2, 3, 4).reshape(nblk, Q_BLOCK, b, h, 2, dk)

    def block(qi):
        s = jnp.einsum('qbhcd,bkhcd->bhcqk', qi, k).astype(jnp.float32)
        p = jax.nn.softmax(s, axis=-1)
        a = p[:, :, 0] - lam * p[:, :, 1]
        return jnp.einsum('bhqk,bkhd->qbhd', a.astype(v.dtype), v)

    o = lax.map(block, qb)
    return o.reshape(l, b, h, v.shape[-1]).transpose(1, 0, 2, 3)


def s5_direction(u_g, a_re, a_im, log_dt, b_re, b_im, c_re, c_im, reverse):
    f32 = jnp.float32
    a_re, a_im = a_re.astype(f32), a_im.astype(f32)
    dt = jnp.exp(log_dt.astype(f32))[:, None]
    mag = jnp.exp(a_re * dt)
    lb_re, lb_im = mag * jnp.cos(a_im * dt), mag * jnp.sin(a_im * dt)
    den = a_re * a_re + a_im * a_im
    n_re, n_im = lb_re - 1.0, lb_im
    f_re = (n_re * a_re + n_im * a_im) / den
    f_im = (n_im * a_re - n_re * a_im) / den
    b_re, b_im = b_re.astype(f32), b_im.astype(f32)
    bb_re = f_re[..., None] * b_re - f_im[..., None] * b_im
    bb_im = f_re[..., None] * b_im + f_im[..., None] * b_re
    bu_re = jnp.einsum('lbgs,gps->lbgp', u_g, bb_re)
    bu_im = jnp.einsum('lbgs,gps->lbgp', u_g, bb_im)
    l = u_g.shape[0]
    ar = jnp.broadcast_to(lb_re[None, None], (l, 1) + lb_re.shape)
    ai = jnp.broadcast_to(lb_im[None, None], (l, 1) + lb_im.shape)

    def combine(e1, e2):
        a1r, a1i, b1r, b1i = e1
        a2r, a2i, b2r, b2i = e2
        return (a2r * a1r - a2i * a1i,
                a2r * a1i + a2i * a1r,
                a2r * b1r - a2i * b1i + b2r,
                a2r * b1i + a2i * b1r + b2i)

    _, _, xr, xi = lax.associative_scan(combine, (ar, ai, bu_re, bu_im), reverse=reverse, axis=0)
    return (jnp.einsum('lbgp,gsp->lbgs', xr, c_re.astype(f32))
            - jnp.einsum('lbgp,gsp->lbgs', xi, c_im.astype(f32)))


def setup_inputs(seed: int = 0) -> dict:
    key = jax.random.key(seed)
    ks = jax.random.split(key, 24)
    f32 = jnp.float32

    def nrm(k, shape, s):
        return jax.random.normal(k, shape, f32) * s

    x = nrm(ks[0], (BATCH, SEQ, D_MODEL), 1.0)
    c = nrm(ks[1], (BATCH, D_MODEL), 1.0)
    positions = (jnp.arange(SEQ, dtype=jnp.int32)[None, :]
                 + jax.random.randint(ks[2], (BATCH, 1), 0, 1024, dtype=jnp.int32))
    norm_g = 1.0 + nrm(ks[3], (DEPTH, D_MODEL), 0.02)
    w_ada = nrm(ks[4], (DEPTH, D_MODEL, 3 * D_MODEL), D_MODEL ** -0.5)
    b_ada = nrm(ks[5], (DEPTH, 3 * D_MODEL), 0.02)
    w_in = nrm(ks[6], (DEPTH, D_MODEL, D_IN), D_MODEL ** -0.5)
    w_out = nrm(ks[7], (DEPTH, D_MIX, D_MODEL), D_MIX ** -0.5)
    lam_q1 = nrm(ks[8], (DEPTH, QK_DIM), 0.1)
    lam_k1 = nrm(ks[9], (DEPTH, QK_DIM), 0.1)
    lam_q2 = nrm(ks[10], (DEPTH, QK_DIM), 0.1)
    lam_k2 = nrm(ks[11], (DEPTH, QK_DIM), 0.1)
    subln_g = 1.0 + nrm(ks[12], (DEPTH, V_DIM), 0.02)
    a_re = -0.5 + nrm(ks[13], (DEPTH, 2, N_GROUPS, STATE), 0.01)
    a_im = (math.pi * jnp.arange(STATE, dtype=f32)
            + nrm(ks[14], (DEPTH, 2, N_GROUPS, STATE), 0.01))
    log_dt = jax.random.uniform(ks[15], (DEPTH, 2, N_GROUPS), f32,
                                minval=math.log(DT_MIN), maxval=math.log(DT_MAX))
    b_re = nrm(ks[16], (DEPTH, 2, N_GROUPS, STATE, SSM_GROUP), (2 * SSM_GROUP) ** -0.5)
    b_im = nrm(ks[17], (DEPTH, 2, N_GROUPS, STATE, SSM_GROUP), (2 * SSM_GROUP) ** -0.5)
    c_re = nrm(ks[18], (DEPTH, 2, N_GROUPS, SSM_GROUP, STATE), (2 * STATE) ** -0.5)
    c_im = nrm(ks[19], (DEPTH, 2, N_GROUPS, SSM_GROUP, STATE), (2 * STATE) ** -0.5)
    d_skip = nrm(ks[20], (DEPTH, D_SSM), 1.0)
    w_glu = nrm(ks[21], (DEPTH, D_SSM, 2 * D_SSM), D_SSM ** -0.5)
    b_glu = nrm(ks[22], (DEPTH, 2 * D_SSM), 0.02)
    final_g = 1.0 + nrm(ks[23], (D_MODEL,), 0.02)
    return {"x": x, "c": c, "positions": positions, "norm_g": norm_g,
            "w_ada": w_ada, "b_ada": b_ada, "w_in": w_in, "w_out": w_out,
            "lam_q1": lam_q1, "lam_k1": lam_k1, "lam_q2": lam_q2, "lam_k2": lam_k2,
            "subln_g": subln_g, "a_re": a_re, "a_im": a_im, "log_dt": log_dt,
            "b_re": b_re, "b_im": b_im, "c_re": c_re, "c_im": c_im,
            "d_skip": d_skip, "w_glu": w_glu, "b_glu": b_glu, "final_g": final_g}


def reference(x, c, positions, norm_g, w_ada, b_ada, w_in, w_out, lam_q1, lam_k1,
              lam_q2, lam_k2, subln_g, a_re, a_im, log_dt, b_re, b_im, c_re, c_im,
              d_skip, w_glu, b_glu, final_g):
    b, l, _ = x.shape
    cond = jax.nn.silu(c)
    splits = [D_QK, 2 * D_QK, 2 * D_QK + D_ATTN, 2 * D_QK + 2 * D_ATTN,
              2 * D_QK + 2 * D_ATTN + D_SSM]
    for i in range(DEPTH):
        lam_init = 0.8 - 0.6 * math.exp(-0.3 * i)
        mod = cond @ w_ada[i] + b_ada[i]
        shift, scale, gate = jnp.split(mod, 3, axis=-1)
        h = rmsnorm(x, norm_g[i]) * (1.0 + scale[:, None, :]) + shift[:, None, :]
        proj = h @ w_in[i]
        q, k, v, z_a, u, z_s = jnp.split(proj, splits, axis=-1)

        q = partial_rotary(q.reshape(b, l, N_HEADS, 2, QK_DIM), positions)
        k = partial_rotary(k.reshape(b, l, N_HEADS, 2, QK_DIM), positions)
        v = v.reshape(b, l, N_HEADS, V_DIM)
        lam = (jnp.exp(jnp.sum(lam_q1[i].astype(jnp.float32) * lam_k1[i].astype(jnp.float32)))
               - jnp.exp(jnp.sum(lam_q2[i].astype(jnp.float32) * lam_k2[i].astype(jnp.float32)))
               + lam_init)
        o_a = diff_attention(q, k, v, lam)
        o_a = rmsnorm(o_a, subln_g[i]) * (1.0 - lam_init)
        o_a = o_a.reshape(b, l, D_ATTN) * jax.nn.silu(z_a)

        ug = u.astype(jnp.float32).reshape(b, l, N_GROUPS, SSM_GROUP).transpose(1, 0, 2, 3)
        y = (s5_direction(ug, a_re[i, 0], a_im[i, 0], log_dt[i, 0], b_re[i, 0], b_im[i, 0],
                          c_re[i, 0], c_im[i, 0], False)
             + s5_direction(ug, a_re[i, 1], a_im[i, 1], log_dt[i, 1], b_re[i, 1], b_im[i, 1],
                            c_re[i, 1], c_im[i, 1], True)
             + d_skip[i].astype(jnp.float32).reshape(N_GROUPS, SSM_GROUP) * ug)
        y = y.transpose(1, 0, 2, 3).reshape(b, l, D_SSM).astype(x.dtype)
        y = jax.nn.gelu(y)
        y_lin, y_gate = jnp.split(y @ w_glu[i] + b_glu[i], 2, axis=-1)
        o_s = y_lin * jax.nn.sigmoid(y_gate) * jax.nn.silu(z_s)

        out = jnp.concatenate([o_a, o_s], axis=-1) @ w_out[i]
        x = x + gate[:, None, :] * out
    return rmsnorm(x, final_g)
```

```cpp
#include <hip/hip_runtime.h>
#include <hip/hip_cooperative_groups.h>
#include <cstdio>
#include <cstdint>
#include <cmath>
namespace cg = cooperative_groups;
#ifndef PROBE_SYNC
#define PROBE_SYNC 0
#endif
#ifndef PROBE_ATT
#define PROBE_ATT 0
#endif
#ifndef PROBE_INPROJ
#define PROBE_INPROJ 0
#endif
#ifndef PROBE_EPI
#define PROBE_EPI 0
#endif
#ifndef PROBE_EXP
#define PROBE_EXP 0
#endif
#ifndef INPROJ_SP2
#define INPROJ_SP2 true
#endif
#ifndef PROBE_SSM
#define PROBE_SSM 0
#endif
#ifndef PROBE_GLU
#define PROBE_GLU 0
#endif
#ifndef PROBE_P0
#define PROBE_P0 0
#endif

#define LAS __attribute__((address_space(3)))
typedef unsigned short bf16_t;
typedef short bf16x8 __attribute__((ext_vector_type(8)));
typedef short v4i16_t __attribute__((ext_vector_type(4)));
typedef float f32x4 __attribute__((ext_vector_type(4)));
typedef float f32x16 __attribute__((ext_vector_type(16)));
typedef unsigned u32x4 __attribute__((ext_vector_type(4)));
typedef unsigned u32x2 __attribute__((ext_vector_type(2)));

constexpr int NB = 8, SEQ = 2048, DM = 2048, MTOK = NB * SEQ, DIN = 6144, NHEAD = 8, NGRP = 64;
constexpr int TCH = 32, KA = TCH * 16 + 256  , RG = MTOK / TCH  ;
constexpr int PP = 5120;
constexpr int C_K = 1024, C_V = 2048, C_ZA = 3072, C_ZS = 4096;
constexpr float EPS = 1e-6f;
constexpr float QSCALE = 0.125f * 1.4426950408889634f;
constexpr int LDS_BYTES = 139264;
constexpr size_t MiB = 1u << 20;
constexpr size_t WS_MOD = 0, WS_LAMT = 512 * 1024, WS_LAMV = 768 * 1024, WS_BAR = 800 * 1024, BAR_BYTES = 16384, WS_RSS = WS_BAR + BAR_BYTES  , WS_CNT = WS_RSS + 2 * 16384 * 4  , CTL_BYTES = BAR_BYTES + 2 * 16384 * 4 + 2 * 64 * 64 * 4, WS_ROT = 1 * MiB, WS_WIN = 2 * MiB, WS_WOUT = 50 * MiB, WS_WGLU = 66 * MiB,
                 WS_WCAT = 74 * MiB, WS_WST = 170 * MiB, WS_H = 202 * MiB, WS_PROJ = 266 * MiB, WS_ACOMB = 426 * MiB, WS_SBUF = 474 * MiB, WS_YG = 474 * MiB  , WS_END = 506 * MiB;
constexpr size_t WCAT_L = (size_t)NGRP * 512 * KA, WST_L = (size_t)NGRP * 256 * 512, LAMT_L = (size_t)NGRP * 2 * 64 * 2;

__device__ __forceinline__ unsigned cvt_pk_bf16(float lo, float hi) { unsigned r; asm volatile("v_cvt_pk_bf16_f32 %0, %1, %2" : "=v"(r) : "v"(lo), "v"(hi)); return r; }
__device__ __forceinline__ unsigned f2bf(float f) { unsigned u = __builtin_bit_cast(unsigned, f); return (u + 0x7fffu + ((u >> 16) & 1u)) >> 16; }
__device__ __forceinline__ unsigned pk2(float lo, float hi) { return f2bf(lo) | (f2bf(hi) << 16); }
__device__ __forceinline__ float bflo(unsigned w) { return __uint_as_float(w << 16); }
__device__ __forceinline__ float bfhi(unsigned w) { return __uint_as_float(w & 0xffff0000u); }
__device__ __forceinline__ float wave_sum(float v) {
#pragma unroll
    for (int o = 1; o < 64; o <<= 1) v += __shfl_xor(v, o);
    return v;
}
__device__ __forceinline__ int opaque_tid() { int t = threadIdx.x; asm volatile("" : "+v"(t)); return t; }
__device__ __forceinline__ float silu_f(float z) { return z / (1.0f + __expf(-z)); }
__device__ __forceinline__ float sigmoid_f(float z) { return 1.0f / (1.0f + __expf(-z)); }
__device__ __forceinline__ float gelu_tanh_f(float y) { const float t = 0.7978845608028654f * (y + 0.044715f * y * y * y); return y * sigmoid_f(2.0f * t); }


#define XB_TMO      128
#define XB_XCNT(j)  (256  + 64 * (j))
#define XB_XSUB(j)  (1280 + 64 * (j))
#define XB_XGEN(j)  (2304 + 64 * (j))
#define XB_TOP      3328
#define XB_TOPGEN   3392
#define XCD_BAR_WORDS 3456
#define XB_SPIN_CAP (1u << 18)
__device__ __forceinline__ unsigned xb_ld(unsigned* p)              { return __hip_atomic_load(p, __ATOMIC_RELAXED, __HIP_MEMORY_SCOPE_AGENT); }
__device__ __forceinline__ unsigned xb_add(unsigned* p, unsigned v) { return __hip_atomic_fetch_add(p, v, __ATOMIC_RELAXED, __HIP_MEMORY_SCOPE_AGENT); }
__device__ __forceinline__ unsigned xb_xcc_id() { return (unsigned)__builtin_amdgcn_s_getreg((3 << 11) | 20) & 0xFu; }
#define XB_SPIN(cond, bar) do { unsigned _sp = 0; while (cond) { __builtin_amdgcn_s_sleep(1); \
    if ((++_sp & 255u) == 0u) { if (xb_ld(&(bar)[XB_TMO])) break; if (_sp > XB_SPIN_CAP) { atomicAdd(&(bar)[XB_TMO], 1u); break; } } } } while (0)
struct XcdBarrier { unsigned* bar; unsigned x; volatile LAS unsigned* st; };
__device__ __forceinline__ void xcd_barrier_post(unsigned* bar) { if (threadIdx.x == 0) (void)xb_add(&bar[XB_XCNT(xb_xcc_id())], 1u); }
__device__ __forceinline__ void xcd_barrier_complete(unsigned* bar, unsigned x, unsigned& nloc, unsigned& nx) {
    const unsigned G = gridDim.x * gridDim.y * gridDim.z;
    unsigned sum, cnt, mine, sp = 0u;
    for (;;) {
        sum = 0u; cnt = 0u; mine = 0u;
#pragma unroll
        for (unsigned j = 0; j < 16; ++j) { const unsigned c = xb_ld(&bar[XB_XCNT(j)]); sum += c; cnt += (c > 0u) ? 1u : 0u; mine = (j == x) ? c : mine; }
        if (sum == G) break;
        __builtin_amdgcn_s_sleep(1);
        if ((++sp & 255u) == 0u) { if (xb_ld(&bar[XB_TMO])) break; if (sp > XB_SPIN_CAP) { atomicAdd(&bar[XB_TMO], 1u); break; } }
    }
    nloc = mine > 0u ? mine : 1u; nx = cnt > 0u ? cnt : 1u;
}
__device__ __forceinline__ void xcd_barrier(const XcdBarrier& b) {
    asm volatile("s_waitcnt vmcnt(0)" ::: "memory");
    __syncthreads();
    if (threadIdx.x == 0) {
        unsigned* bar = b.bar;
        __builtin_amdgcn_s_waitcnt(0);
        unsigned nloc = b.st[0], nx = b.st[1];
        if (nloc == 0u) { xcd_barrier_complete(bar, b.x, nloc, nx); b.st[0] = nloc; b.st[1] = nx; }
        const unsigned old = xb_add(&bar[XB_XSUB(b.x)], 1u);
        const unsigned gen = old / nloc;
        if (old + 1u == (gen + 1u) * nloc) {
            __builtin_amdgcn_fence(__ATOMIC_RELEASE, "agent");
            asm volatile("s_waitcnt vmcnt(0)" ::: "memory");
            const unsigned og = xb_add(&bar[XB_TOP], 1u);
            const unsigned tg = og / nx;
            if (og + 1u == (tg + 1u) * nx) xb_add(&bar[XB_TOPGEN], 1u);
            else XB_SPIN(xb_ld(&bar[XB_TOPGEN]) == tg, bar);
            __builtin_amdgcn_fence(__ATOMIC_ACQUIRE, "agent");
            xb_add(&bar[XB_XGEN(b.x)], 1u);
            asm volatile("s_waitcnt vmcnt(0)" ::: "memory");
        } else {
            XB_SPIN(xb_ld(&bar[XB_XGEN(b.x)]) == gen, bar);
            __builtin_amdgcn_fence(__ATOMIC_ACQUIRE, "agent");
            asm volatile("s_waitcnt vmcnt(0)" ::: "memory");
        }
    }
    __syncthreads();
}

namespace pg8 {
constexpr int BM = 256, BK = 64, HALF = 128, HTB = HALF * BK * 2, STAGE_BYTES = 8 * HTB, NXCD = 8, WGM = 8;
__device__ __forceinline__ int lds_byte(int r, int c) { const int st = (r >> 4) * 2 + (c >> 5), rr = r & 15, cc = c & 31, ob = rr * 64 + cc * 2; return st * 1024 + (ob ^ (((ob >> 9) & 1) << 5)); }
__device__ __forceinline__ void stage_rc(int b, int& R, int& C) { const int st = b / 1024, sb = b % 1024, swz = sb ^ (((sb >> 9) & 1) << 5); R = (st >> 1) * 16 + swz / 64; C = (st & 1) * 32 + (swz % 64) / 2; }
__device__ __forceinline__ int perm32(int rho) { const int n = rho >> 4, i = rho & 15; return 8 * (i >> 2) + 4 * n + (i & 3); }

struct Unit { int pm, pn, g; const char* A; const char* B; };

struct StaticOrder {
    int nM, nN, nwg, G, c; const char* A; const char* B; unsigned tA, tB;
    __device__ void init(int M, int N, int G_, int c_, const void* A_, const void* B_, int lda, int ldb) { nM = M / BM; nN = N / BM; nwg = nM * nN; G = G_; c = c_; A = (const char*)A_; B = (const char*)B_; tA = (unsigned)(BM * lda * 2); tB = (unsigned)(BM * ldb * 2); }
    __device__ bool next(int i, Unit& u) const {
        const long L = (long)i * G + c; if (L >= nwg) return false;
        int wgid = (int)L; { const int q = nwg / NXCD, r = nwg % NXCD, xcd = wgid % NXCD, off = wgid / NXCD; wgid = (xcd < r ? xcd * (q + 1) : r * (q + 1) + (xcd - r) * q) + off; }
        const int nig = WGM * nN, gid = wgid / nig, fm = gid * WGM, gsz = (nM - fm) < WGM ? (nM - fm) : WGM;
        u.pm = fm + ((wgid % nig) % gsz); u.pn = (wgid % nig) / gsz; u.g = 0; u.A = A + (size_t)u.pm * tA; u.B = B + (size_t)u.pn * tB; return true;
    }
};
struct GroupOrder {
    int nwg, G, c, tM, tN; const char* A; const char* B; unsigned sA, sB, tA, tB;
    __device__ void init(int ngrp, int tM_, int tN_, int G_, int c_, const void* A_, const void* B_, int lda, int ldb, size_t sA_, size_t sB_) { tM = tM_; tN = tN_; nwg = ngrp * tM * tN; G = G_; c = c_; A = (const char*)A_; B = (const char*)B_; sA = (unsigned)sA_; sB = (unsigned)sB_; tA = (unsigned)(BM * lda * 2); tB = (unsigned)(BM * ldb * 2); }
    __device__ bool next(int i, Unit& u) const {
        const long L = (long)i * G + c; if (L >= nwg) return false;
        const int per = tM * tN, g = (int)L / per, r = (int)L % per; u.g = g; u.pm = r % tM; u.pn = r / tM;
        u.A = A + (size_t)g * sA + (size_t)u.pm * tA; u.B = B + (size_t)g * sB + (size_t)u.pn * tB; return true;
    }
};

struct PanelOrder {
    int c; const char* A; const char* B; unsigned tA, tB;
    __device__ void init(int c_, const void* A_, const void* B_, int lda, int ldb) { c = c_; A = (const char*)A_; B = (const char*)B_; tA = (unsigned)(BM * lda * 2); tB = (unsigned)(BM * ldb * 2); }
    __device__ bool next(int i, Unit& u) const {
        if (i >= 2) return false;
        const int x = c & 7, j = c >> 3; u.pn = j & 7; u.pm = i * 32 + x * 4 + (j >> 3); u.g = 0; u.A = A + (size_t)u.pm * tA; u.B = B + (size_t)u.pn * tB; return true;
    }
};

template <bool SP2 = true, class Epi, class Sched>
__device__ __forceinline__ void gemm_phase(LAS unsigned char* lds, const int K, const int lda, const int ldb, const Sched& S, const Epi& E) {
    const int tid = opaque_tid(), wid = __builtin_amdgcn_readfirstlane(tid >> 6), lane = tid & 63, wr = wid >> 2, wc = wid & 3, fr = lane & 15, fq = lane >> 4;
    const int nt = K / BK;
    unsigned voffA[2], voffB[2];
#pragma unroll
    for (int i = 0; i < 2; ++i) { int R, C; stage_rc(tid * 16 + i * 8192, R, C); const int Rb = (R & ~31) + perm32(R & 31);
        voffA[i] = (unsigned)(R * lda + C) * 2u; voffB[i] = (unsigned)(Rb * ldb + C) * 2u; }
    constexpr unsigned kstep = (unsigned)(BK * 2);
    const unsigned hstepA = (unsigned)(HALF * lda * 2), hstepB = (unsigned)(HALF * ldb * 2);
    const unsigned ldsw = (unsigned)wid * 1024u;
    const int aoff = lds_byte(wr * 64 + fr, fq * 8), boff = lds_byte(wc * 32 + fr, fq * 8);
#define PG8_SA(b, h) (((b) * 2 + (h)) * HTB)
#define PG8_SB(b, h) ((4 + (b) * 2 + (h)) * HTB)
#define PG8_STAGE(bufoff, gbase, voff) do { _Pragma("unroll") for (int _i = 0; _i < 2; ++_i) \
        __builtin_amdgcn_global_load_lds((const unsigned*)((const char*)(gbase) + (voff)[_i]), (LAS unsigned*)(lds + (bufoff) + ldsw + _i * 8192), 16, 0, 0); } while (0)
#define PG8_LDA(dst, b, h) do { _Pragma("unroll") for (int m = 0; m < 4; ++m) _Pragma("unroll") for (int k = 0; k < 2; ++k) dst[m][k] = *(const LAS bf16x8*)(lds + PG8_SA(b, h) + aoff + m * 2048 + k * 1024); } while (0)
#define PG8_LDB(dst, b, h) do { _Pragma("unroll") for (int n = 0; n < 2; ++n) _Pragma("unroll") for (int k = 0; k < 2; ++k) dst[n][k] = *(const LAS bf16x8*)(lds + PG8_SB(b, h) + boff + n * 2048 + k * 1024); } while (0)
#define PG8_MMA(ai, bj, At, Bt) do { __builtin_amdgcn_s_setprio(1); _Pragma("unroll") for (int m = 0; m < 4; ++m) _Pragma("unroll") for (int n = 0; n < 2; ++n) _Pragma("unroll") for (int k = 0; k < 2; ++k) \
        acc[ai][bj][m][n] = __builtin_amdgcn_mfma_f32_16x16x32_bf16(Bt[n][k], At[m][k], acc[ai][bj][m][n], 0, 0, 0); __builtin_amdgcn_s_setprio(0); } while (0)
#define PG8_WAIT_V(n) asm volatile("s_waitcnt vmcnt(" #n ")" ::: "memory")
#define PG8_WAIT_L(n) asm volatile("s_waitcnt lgkmcnt(" #n ")" ::: "memory")
#define PG8_BAR __builtin_amdgcn_s_barrier()
#define PG8_SCHED __builtin_amdgcn_sched_barrier(0)
    Unit cur, nxt; int ui = 0;
    if (!S.next(0, cur)) return;
    f32x4 acc[2][2][4][2];
#pragma unroll
    for (int a = 0; a < 2; ++a)
#pragma unroll
        for (int b = 0; b < 2; ++b)
#pragma unroll
            for (int m = 0; m < 4; ++m)
#pragma unroll
                for (int n = 0; n < 2; ++n) acc[a][b][m][n] = (f32x4){0.f, 0.f, 0.f, 0.f};
    bf16x8 At[4][2], B0[2][2], B1[2][2];
    const char* cA = cur.A; const char* cB = cur.B;
    if constexpr (SP2) {
    PG8_STAGE(PG8_SB(0, 0), cB, voffB); PG8_STAGE(PG8_SB(0, 1), cB + hstepB, voffB); PG8_STAGE(PG8_SA(0, 0), cA, voffA); PG8_STAGE(PG8_SA(0, 1), cA + hstepA, voffA);
    if (wr == 1) PG8_BAR;
    PG8_WAIT_V(2); PG8_BAR;
    PG8_STAGE(PG8_SB(1, 0), cB + kstep, voffB); PG8_STAGE(PG8_SA(1, 0), cA + kstep, voffA); PG8_STAGE(PG8_SB(1, 1), cB + hstepB + kstep, voffB);
    PG8_WAIT_V(6); PG8_BAR;
    } else {
    PG8_STAGE(PG8_SB(0, 0), cB, voffB); PG8_STAGE(PG8_SA(0, 0), cA, voffA); PG8_STAGE(PG8_SB(0, 1), cB + hstepB, voffB); PG8_STAGE(PG8_SA(0, 1), cA + hstepA, voffA);
    if (wr == 1) PG8_BAR;
    PG8_WAIT_V(4); PG8_BAR;
    PG8_STAGE(PG8_SB(1, 0), cB + kstep, voffB); PG8_STAGE(PG8_SA(1, 0), cA + kstep, voffA); PG8_STAGE(PG8_SB(1, 1), cB + hstepB + kstep, voffB);
    PG8_WAIT_V(6); PG8_BAR;
    }
    for (;;) {
        const bool has_next = S.next(ui + 1, nxt);
        const char* nA = has_next ? nxt.A : cA; const char* nB = has_next ? nxt.B : cB;
        for (int t = 0; t < nt; t += 2) {
            const bool last = (t == nt - 2);
            const char* a1 = cA + (unsigned)(t + 1) * kstep;
            const char* a2 = last ? nA : cA + (unsigned)(t + 2) * kstep; const char* b2 = last ? nB : cB + (unsigned)(t + 2) * kstep;
            const char* a3 = a2 + kstep; const char* b3 = b2 + kstep;
            if constexpr (SP2) {
            PG8_LDB(B0, 0, 0); PG8_LDB(B1, 0, 1); PG8_SCHED; PG8_LDA(At, 0, 0); PG8_STAGE(PG8_SA(1, 1), a1 + hstepA, voffA);
            PG8_WAIT_V(8); PG8_WAIT_L(0); PG8_BAR; PG8_MMA(0, 0, At, B0); PG8_MMA(0, 1, At, B1); PG8_BAR; PG8_SCHED;
            PG8_LDA(At, 0, 1); PG8_STAGE(PG8_SB(0, 0), b2, voffB); PG8_STAGE(PG8_SB(0, 1), b2 + hstepB, voffB); PG8_STAGE(PG8_SA(0, 0), a2, voffA);
            PG8_WAIT_V(8); PG8_WAIT_L(0); PG8_BAR; PG8_MMA(1, 0, At, B0); PG8_MMA(1, 1, At, B1); PG8_BAR; PG8_SCHED;
            PG8_LDB(B0, 1, 0); PG8_LDB(B1, 1, 1); PG8_SCHED; PG8_LDA(At, 1, 0); PG8_STAGE(PG8_SA(0, 1), a2 + hstepA, voffA);
            PG8_WAIT_V(8); PG8_WAIT_L(0); PG8_BAR; PG8_MMA(0, 0, At, B0); PG8_MMA(0, 1, At, B1); PG8_BAR; PG8_SCHED;
            PG8_LDA(At, 1, 1); PG8_STAGE(PG8_SB(1, 0), b3, voffB); PG8_STAGE(PG8_SB(1, 1), b3 + hstepB, voffB); PG8_STAGE(PG8_SA(1, 0), a3, voffA);
            PG8_WAIT_V(8); PG8_WAIT_L(0); PG8_BAR; PG8_MMA(1, 0, At, B0); PG8_MMA(1, 1, At, B1); PG8_BAR; PG8_SCHED;
            } else {
            PG8_LDB(B0, 0, 0); PG8_SCHED; PG8_LDA(At, 0, 0); PG8_STAGE(PG8_SA(1, 1), a1 + hstepA, voffA);
            PG8_WAIT_L(8); PG8_BAR; PG8_WAIT_L(0); PG8_MMA(0, 0, At, B0); PG8_BAR; PG8_SCHED;
            PG8_LDB(B1, 0, 1); PG8_STAGE(PG8_SB(0, 0), b2, voffB);
            PG8_BAR; PG8_WAIT_L(0); PG8_MMA(0, 1, At, B1); PG8_BAR;
            PG8_LDA(At, 0, 1); PG8_STAGE(PG8_SA(0, 0), a2, voffA);
            PG8_BAR; PG8_WAIT_L(0); PG8_MMA(1, 0, At, B0); PG8_BAR; PG8_SCHED;
            PG8_STAGE(PG8_SB(0, 1), b2 + hstepB, voffB);
            PG8_WAIT_V(6); PG8_BAR; PG8_MMA(1, 1, At, B1); PG8_BAR;
            PG8_LDB(B0, 1, 0); PG8_SCHED; PG8_LDA(At, 1, 0); PG8_STAGE(PG8_SA(0, 1), a2 + hstepA, voffA);
            PG8_WAIT_L(8); PG8_BAR; PG8_WAIT_L(0); PG8_MMA(0, 0, At, B0); PG8_BAR; PG8_SCHED;
            PG8_LDB(B1, 1, 1); PG8_STAGE(PG8_SB(1, 0), b3, voffB);
            PG8_BAR; PG8_WAIT_L(0); PG8_MMA(0, 1, At, B1); PG8_BAR;
            PG8_LDA(At, 1, 1); PG8_STAGE(PG8_SA(1, 0), a3, voffA);
            PG8_BAR; PG8_WAIT_L(0); PG8_MMA(1, 0, At, B0); PG8_BAR; PG8_SCHED;
            PG8_STAGE(PG8_SB(1, 1), b3 + hstepB, voffB);
            PG8_WAIT_V(6); PG8_BAR; PG8_MMA(1, 1, At, B1); PG8_BAR;
            }
        }
        if (wr == 0) PG8_BAR;
        if constexpr (Epi::FUSED) E.fused(acc, cur, wr, wc, fr, fq, lds, tid); else E(acc, cur, wr, wc, fr, fq);
        if (!has_next) break;
#pragma unroll
        for (int a = 0; a < 2; ++a)
#pragma unroll
            for (int b = 0; b < 2; ++b)
#pragma unroll
                for (int m = 0; m < 4; ++m)
#pragma unroll
                    for (int n = 0; n < 2; ++n) acc[a][b][m][n] = (f32x4){0.f, 0.f, 0.f, 0.f};
        cur = nxt; cA = nA; cB = nB; ++ui;
        if (wr == 1) PG8_BAR;
    }
    PG8_WAIT_V(0);
    PG8_BAR;
#undef PG8_SA
#undef PG8_SB
#undef PG8_STAGE
#undef PG8_LDA
#undef PG8_LDB
#undef PG8_MMA
#undef PG8_WAIT_V
#undef PG8_WAIT_L
#undef PG8_BAR
#undef PG8_SCHED
}
}
using pg8::Unit;
typedef f32x4 AccT[2][2][4][2];

struct EpiInProj {
    static constexpr bool FUSED = false;
    unsigned char* ws;
    __device__ __forceinline__ void operator()(const AccT& acc, const Unit& u, int wr, int wc, int fr, int fq) const {
        bf16_t* PROJ = (bf16_t*)(ws + WS_PROJ); bf16_t* ACOMB = (bf16_t*)(ws + WS_ACOMB); const float* ROT = (const float*)(ws + WS_ROT);
        const int colt = u.pn * 256, region = colt >> 10;
        if (region < 2) {
            const float qs = (region == 0) ? QSCALE : 1.0f;
            const bool rotl = ((wc & 1) == 0) && (fq < 2);
            const float sg = (fq == 0) ? -1.0f : 1.0f;
#pragma unroll
            for (int ai = 0; ai < 2; ++ai)
#pragma unroll
                for (int m = 0; m < 4; ++m) {
                    const int row = u.pm * 256 + ai * 128 + wr * 64 + m * 16 + fr;
                    const f32x4* rt = (const f32x4*)(ROT + (size_t)row * 16);
                    const f32x4 c0 = rt[0], c1 = rt[1], s0 = rt[2], s1 = rt[3];
#pragma unroll
                    for (int bj = 0; bj < 2; ++bj) {
                        const int col0 = colt + bj * 128 + wc * 32 + 8 * fq;
                        f32x4 v0 = acc[ai][bj][m][0], v1 = acc[ai][bj][m][1];
                        f32x4 p0, p1;
#pragma unroll
                        for (int e = 0; e < 4; ++e) { p0[e] = __shfl_xor(v0[e], 16); p1[e] = __shfl_xor(v1[e], 16); }
                        const f32x4 r0 = v0 * c0 + sg * (p0 * s0), r1 = v1 * c1 + sg * (p1 * s1);
                        v0 = rotl ? r0 : v0; v1 = rotl ? r1 : v1;
                        v0 = v0 * qs; v1 = v1 * qs;
                        u32x4 w; w.x = cvt_pk_bf16(v0[0], v0[1]); w.y = cvt_pk_bf16(v0[2], v0[3]); w.z = cvt_pk_bf16(v1[0], v1[1]); w.w = cvt_pk_bf16(v1[2], v1[3]);
                        *(u32x4*)(PROJ + (size_t)row * PP + col0) = w;
                    }
                    if (m & 1) asm volatile("" ::: "memory");
                }
        } else {
#pragma unroll
            for (int ai = 0; ai < 2; ++ai)
#pragma unroll
                for (int m = 0; m < 4; ++m) {
                    const int row = u.pm * 256 + ai * 128 + wr * 64 + m * 16 + fr;
#pragma unroll
                    for (int bj = 0; bj < 2; ++bj) {
                        const int col0 = colt + bj * 128 + wc * 32 + 8 * fq;
                        const f32x4 v0 = acc[ai][bj][m][0], v1 = acc[ai][bj][m][1];
                        u32x4 w; w.x = cvt_pk_bf16(v0[0], v0[1]); w.y = cvt_pk_bf16(v0[2], v0[3]); w.z = cvt_pk_bf16(v1[0], v1[1]); w.w = cvt_pk_bf16(v1[2], v1[3]);
                        if (region == 4) {
                            const int uc = col0 - 4096, g = uc >> 4, s0 = uc & 15;
                            *(u32x4*)(ACOMB + ((size_t)g * RG + (row >> 5)) * KA + (row & 31) * 16 + s0) = w;
                        } else {
                            const int pc = (region == 5) ? col0 - 1024 : col0;
                            *(u32x4*)(PROJ + (size_t)row * PP + pc) = w;
                        }
                    }
                    asm volatile("" ::: "memory");
                }
        }
    }
};
struct EpiS1 {
    static constexpr bool FUSED = false;
    float* SBUF;
    __device__ __forceinline__ void operator()(const AccT& acc, const Unit& u, int wr, int wc, int fr, int fq) const {
#pragma unroll
        for (int ai = 0; ai < 2; ++ai)
#pragma unroll
            for (int m = 0; m < 4; ++m) {
                const int row = u.pm * 256 + ai * 128 + wr * 64 + m * 16 + fr;
                float* rp = SBUF + ((size_t)u.g * RG + row) * 256 + u.pn * 256 + wc * 32 + 8 * fq;
#pragma unroll
                for (int bj = 0; bj < 2; ++bj) { *(f32x4*)(rp + bj * 128) = acc[ai][bj][m][0]; *(f32x4*)(rp + bj * 128 + 4) = acc[ai][bj][m][1]; }
            }
    }
};
struct EpiS3 {
    static constexpr bool FUSED = false;
    bf16_t* YG;
    __device__ __forceinline__ void operator()(const AccT& acc, const Unit& u, int wr, int wc, int fr, int fq) const {
#pragma unroll
        for (int ai = 0; ai < 2; ++ai)
#pragma unroll
            for (int m = 0; m < 4; ++m) {
                const int rg = u.pm * 256 + ai * 128 + wr * 64 + m * 16 + fr;
#pragma unroll
                for (int bj = 0; bj < 2; ++bj) {
                    const int nc = u.pn * 256 + bj * 128 + wc * 32 + 8 * fq, i = nc >> 4, s0 = nc & 15;
                    const f32x4 v0 = acc[ai][bj][m][0], v1 = acc[ai][bj][m][1];
                    u32x4 w; w.x = cvt_pk_bf16(gelu_tanh_f(v0[0]), gelu_tanh_f(v0[1])); w.y = cvt_pk_bf16(gelu_tanh_f(v0[2]), gelu_tanh_f(v0[3]));
                    w.z = cvt_pk_bf16(gelu_tanh_f(v1[0]), gelu_tanh_f(v1[1])); w.w = cvt_pk_bf16(gelu_tanh_f(v1[2]), gelu_tanh_f(v1[3]));
                    *(u32x4*)(YG + ((size_t)rg * 32 + i) * 1024 + u.g * 16 + s0) = w;
                }
            }
    }
};
struct EpiGLU {
    static constexpr bool FUSED = false;
    unsigned char* ws; const float* bglu;
    __device__ __forceinline__ void operator()(const AccT& acc, const Unit& u, int wr, int wc, int fr, int fq) const {
        bf16_t* OCAT = (bf16_t*)(ws + WS_H); const bf16_t* PROJ = (const bf16_t*)(ws + WS_PROJ);
        const int lc = u.pn * 128 + wc * 32 + 8 * fq;
        const f32x4 bl0 = *(const f32x4*)(bglu + lc), bl1 = *(const f32x4*)(bglu + lc + 4), bg0 = *(const f32x4*)(bglu + 1024 + lc), bg1 = *(const f32x4*)(bglu + 1024 + lc + 4);
#pragma unroll
        for (int ai = 0; ai < 2; ++ai)
#pragma unroll
            for (int m = 0; m < 4; ++m) {
                const int row = u.pm * 256 + ai * 128 + wr * 64 + m * 16 + fr;
                const u32x4 z = *(const u32x4*)(PROJ + (size_t)row * PP + C_ZS + lc);
                const f32x4 l0 = acc[ai][0][m][0] + bl0, l1 = acc[ai][0][m][1] + bl1, g0 = acc[ai][1][m][0] + bg0, g1 = acc[ai][1][m][1] + bg1;
                float o[8];
                o[0] = l0[0] * sigmoid_f(g0[0]) * silu_f(bflo(z.x)); o[1] = l0[1] * sigmoid_f(g0[1]) * silu_f(bfhi(z.x));
                o[2] = l0[2] * sigmoid_f(g0[2]) * silu_f(bflo(z.y)); o[3] = l0[3] * sigmoid_f(g0[3]) * silu_f(bfhi(z.y));
                o[4] = l1[0] * sigmoid_f(g1[0]) * silu_f(bflo(z.z)); o[5] = l1[1] * sigmoid_f(g1[1]) * silu_f(bfhi(z.z));
                o[6] = l1[2] * sigmoid_f(g1[2]) * silu_f(bflo(z.w)); o[7] = l1[3] * sigmoid_f(g1[3]) * silu_f(bfhi(z.w));
                u32x4 w; w.x = cvt_pk_bf16(o[0], o[1]); w.y = cvt_pk_bf16(o[2], o[3]); w.z = cvt_pk_bf16(o[4], o[5]); w.w = cvt_pk_bf16(o[6], o[7]);
                *(u32x4*)(OCAT + (size_t)row * 2048 + 1024 + lc) = w;
                if (m == 3) asm volatile("" ::: "memory");
            }
    }
};
struct EpiOut {
    static constexpr bool FUSED = false;
    const float* xold; float* xnew; const float* gate;
    __device__ __forceinline__ void operator()(const AccT& acc, const Unit& u, int wr, int wc, int fr, int fq) const {
        const int bb = u.pm >> 3;
#pragma unroll
        for (int bj = 0; bj < 2; ++bj) {
            const int col0 = u.pn * 256 + bj * 128 + wc * 32 + 8 * fq;
            const f32x4 gt0 = *(const f32x4*)(gate + (size_t)bb * 6144 + col0), gt1 = *(const f32x4*)(gate + (size_t)bb * 6144 + col0 + 4);
#pragma unroll
            for (int ai = 0; ai < 2; ++ai)
#pragma unroll
                for (int m = 0; m < 4; ++m) {
                    const size_t off = (size_t)(u.pm * 256 + ai * 128 + wr * 64 + m * 16 + fr) * DM + col0;
                    const f32x4 x0 = *(const f32x4*)(xold + off), x1 = *(const f32x4*)(xold + off + 4);
                    *(f32x4*)(xnew + off) = x0 + gt0 * acc[ai][bj][m][0]; *(f32x4*)(xnew + off + 4) = x1 + gt1 * acc[ai][bj][m][1];
                    asm volatile("" ::: "memory");
                }
        }
    }
};

struct EpiOutNorm {
    static constexpr bool FUSED = true;
    float* OUT; const float* gate; float* rss; unsigned* cnt; const float* g; const float* modn; bf16_t* H; int mode; unsigned char* ws;
    __device__ __forceinline__ bf16_t* x1base(const Unit& u) const { return (bf16_t*)(ws + (u.pm < 48 ? WS_WCAT : WS_WST - (size_t)12288 * 4096)); }
    __device__ __forceinline__ void fused(AccT& acc, const Unit& u, int wr, int wc, int fr, int fq, LAS unsigned char* lds, int tid_unused) const {
        const int tid = opaque_tid();
        LAS float* P = (LAS float*)(lds + 131072);
        LAS float* S = (LAS float*)(lds + 131072 + 4096);
        const int bb = u.pm >> 3;
        bf16_t* const x1b = x1base(u); const bf16_t* const resb = (mode == 0) ? (const bf16_t*)OUT : (const bf16_t*)x1b;
        float ss[2][4];
#pragma unroll
        for (int ai = 0; ai < 2; ++ai)
#pragma unroll
            for (int m = 0; m < 4; ++m) ss[ai][m] = 0.f;
#pragma unroll
        for (int bj = 0; bj < 2; ++bj) {
            const int col0 = u.pn * 256 + bj * 128 + wc * 32 + 8 * fq;
            const f32x4 gt0 = *(const f32x4*)(gate + (size_t)bb * 6144 + col0), gt1 = *(const f32x4*)(gate + (size_t)bb * 6144 + col0 + 4);
#pragma unroll
            for (int ai = 0; ai < 2; ++ai) {
#pragma unroll
                for (int m = 0; m < 4; ++m) {
                    const int row_ = u.pm * 256 + ai * 128 + wr * 64 + m * 16 + fr;
                    const u32x4 xb = *(const u32x4*)(resb + (size_t)row_ * DM + col0);
                    const f32x4 x0 = (f32x4){bflo(xb.x), bfhi(xb.x), bflo(xb.y), bfhi(xb.y)}, x1 = (f32x4){bflo(xb.z), bfhi(xb.z), bflo(xb.w), bfhi(xb.w)};
                    const f32x4 v0 = x0 + gt0 * acc[ai][bj][m][0], v1 = x1 + gt1 * acc[ai][bj][m][1];
                    acc[ai][bj][m][0] = v0; acc[ai][bj][m][1] = v1;
                    ss[ai][m] += (v0[0] * v0[0] + v0[1] * v0[1]) + (v0[2] * v0[2] + v0[3] * v0[3]) + (v1[0] * v1[0] + v1[1] * v1[1]) + (v1[2] * v1[2] + v1[3] * v1[3]);
                    if (m & 1) asm volatile("" ::: "memory");
                }
            }
        }
#pragma unroll
        for (int ai = 0; ai < 2; ++ai)
#pragma unroll
            for (int m = 0; m < 4; ++m) { float v = ss[ai][m]; v += __shfl_xor(v, 16); v += __shfl_xor(v, 32); if (fq == 0) P[(ai * 128 + wr * 64 + m * 16 + fr) * 4 + wc] = v; }
        asm volatile("s_waitcnt lgkmcnt(0)" ::: "memory"); __builtin_amdgcn_s_barrier(); asm volatile("" ::: "memory");
        if (tid < 256) { const f32x4 p = *(const LAS f32x4*)(P + tid * 4);
            (void)__hip_atomic_fetch_add(rss + u.pm * 256 + tid, (p[0] + p[1]) + (p[2] + p[3]), __ATOMIC_RELAXED, __HIP_MEMORY_SCOPE_AGENT); }
        f32x4 ew0[2], ew1[2], ea0[2], ea1[2];
#pragma unroll
        for (int bj = 0; bj < 2; ++bj) {
            const int col0 = u.pn * 256 + bj * 128 + wc * 32 + 8 * fq;
            ew0[bj] = *(const f32x4*)(g + col0); ew1[bj] = *(const f32x4*)(g + col0 + 4); ea0[bj] = (f32x4){0.f, 0.f, 0.f, 0.f}; ea1[bj] = ea0[bj];
            if (mode == 0) { const float* sh = modn + (size_t)bb * 6144; ea0[bj] = *(const f32x4*)(sh + col0); ea1[bj] = *(const f32x4*)(sh + col0 + 4);
                ew0[bj] = ew0[bj] * (1.0f + *(const f32x4*)(sh + 2048 + col0)); ew1[bj] = ew1[bj] * (1.0f + *(const f32x4*)(sh + 2048 + col0 + 4)); }
        }
        asm volatile("s_waitcnt vmcnt(0)" ::: "memory"); __builtin_amdgcn_s_barrier(); asm volatile("" ::: "memory");
        if (tid < 64) {
            if (tid == 0) (void)__hip_atomic_fetch_add(cnt + u.pm * 64, 1u, __ATOMIC_RELAXED, __HIP_MEMORY_SCOPE_AGENT);
            unsigned sp = 0;
            while ((unsigned)__builtin_amdgcn_readfirstlane(__hip_atomic_load(cnt + u.pm * 64, __ATOMIC_RELAXED, __HIP_MEMORY_SCOPE_AGENT)) < 8u) { __builtin_amdgcn_s_sleep(2); if (++sp > (1u << 22)) break; }
        }
        asm volatile("s_waitcnt vmcnt(0) lgkmcnt(0)" ::: "memory"); __builtin_amdgcn_s_barrier(); asm volatile("" ::: "memory");
        if (tid < 256) { const float t = __hip_atomic_load(rss + u.pm * 256 + tid, __ATOMIC_RELAXED, __HIP_MEMORY_SCOPE_AGENT); S[tid] = rsqrtf(t * (1.0f / DM) + EPS); }
        asm volatile("s_waitcnt vmcnt(0) lgkmcnt(0)" ::: "memory"); __builtin_amdgcn_s_barrier(); asm volatile("" ::: "memory");
#pragma unroll
        for (int bj = 0; bj < 2; ++bj) {
            const int col0 = u.pn * 256 + bj * 128 + wc * 32 + 8 * fq;
            const f32x4 w0 = ew0[bj], w1 = ew1[bj], a0 = ea0[bj], a1 = ea1[bj];
#pragma unroll
            for (int ai = 0; ai < 2; ++ai)
#pragma unroll
                for (int m = 0; m < 4; ++m) {
                    const int r = ai * 128 + wr * 64 + m * 16 + fr; const float rs = S[r];
                    const size_t off = (size_t)(u.pm * 256 + r) * DM + col0;
                    const f32x4 v0 = acc[ai][bj][m][0], v1 = acc[ai][bj][m][1];
                    const f32x4 o0 = v0 * rs * w0 + a0, o1 = v1 * rs * w1 + a1;
                    if (mode == 0) {
                        u32x4 xw; xw.x = cvt_pk_bf16(v0[0], v0[1]); xw.y = cvt_pk_bf16(v0[2], v0[3]); xw.z = cvt_pk_bf16(v1[0], v1[1]); xw.w = cvt_pk_bf16(v1[2], v1[3]); *(u32x4*)(x1b + off) = xw;
                        u32x4 w; w.x = cvt_pk_bf16(o0[0], o0[1]); w.y = cvt_pk_bf16(o0[2], o0[3]); w.z = cvt_pk_bf16(o1[0], o1[1]); w.w = cvt_pk_bf16(o1[2], o1[3]); *(u32x4*)(H + off) = w;
                    } else { *(f32x4*)(OUT + off) = o0; *(f32x4*)(OUT + off + 4) = o1; }
                    asm volatile("" ::: "memory");
                }
        }
        asm volatile("s_waitcnt lgkmcnt(0)" ::: "memory"); __builtin_amdgcn_s_barrier(); asm volatile("" ::: "memory");
    }
};

__device__ __forceinline__ void transpose_item(const float* W, int K, int N, bf16_t* WT, int k0, int n0, int rowbase, LAS float* scr, int lane) {
#pragma unroll
    for (int i = 0; i < 32; ++i) { const int kk = 2 * i + (lane >> 5); scr[kk * 33 + (lane & 31)] = W[(size_t)(k0 + kk) * N + n0 + (lane & 31)]; }
    asm volatile("s_waitcnt lgkmcnt(0)" ::: "memory");
    const int c = lane & 7;
#pragma unroll
    for (int j = 0; j < 4; ++j) { const int n = (lane >> 3) + 8 * j; const LAS float* s = scr + (8 * c) * 33 + n;
        u32x4 o; o.x = pk2(s[0 * 33], s[1 * 33]); o.y = pk2(s[2 * 33], s[3 * 33]); o.z = pk2(s[4 * 33], s[5 * 33]); o.w = pk2(s[6 * 33], s[7 * 33]);
        *(u32x4*)(WT + (size_t)(rowbase + n) * K + k0 + 8 * c) = o; }
    asm volatile("s_waitcnt lgkmcnt(0)" ::: "memory");
}

__device__ __forceinline__ void mod_item(int item, const float* w_ada, const float* b_ada, float* mod, LAS unsigned char* lds, int tid) {
    const int layer = item / 96, col0 = (item % 96) * 64, quad = tid & 15, ks = tid >> 4;
    const LAS float* cond = (const LAS float*)lds; LAS float* red = (LAS float*)(lds + 65536);
    const float* wp = w_ada + ((size_t)layer * 2048 + ks * 64) * 6144 + col0 + quad * 4;
    f32x4 a0 = {0, 0, 0, 0}, a1 = a0, a2 = a0, a3 = a0, a4 = a0, a5 = a0, a6 = a0, a7 = a0;
#pragma unroll 8
    for (int kk = 0; kk < 64; ++kk) {
        const f32x4 w = *(const f32x4*)(wp + (size_t)kk * 6144);
        const f32x4 c0 = *(const LAS f32x4*)(cond + (ks * 64 + kk) * 8), c1 = *(const LAS f32x4*)(cond + (ks * 64 + kk) * 8 + 4);
        a0 += c0[0] * w; a1 += c0[1] * w; a2 += c0[2] * w; a3 += c0[3] * w; a4 += c1[0] * w; a5 += c1[1] * w; a6 += c1[2] * w; a7 += c1[3] * w;
    }
    LAS float* rp = red + (ks * 8) * 64 + quad * 4;
    *(LAS f32x4*)(rp + 0 * 64) = a0; *(LAS f32x4*)(rp + 1 * 64) = a1; *(LAS f32x4*)(rp + 2 * 64) = a2; *(LAS f32x4*)(rp + 3 * 64) = a3;
    *(LAS f32x4*)(rp + 4 * 64) = a4; *(LAS f32x4*)(rp + 5 * 64) = a5; *(LAS f32x4*)(rp + 6 * 64) = a6; *(LAS f32x4*)(rp + 7 * 64) = a7;
    __syncthreads();
    { const int b = tid >> 6, col = tid & 63; float s = 0.f;
#pragma unroll 8
      for (int k2 = 0; k2 < 32; ++k2) s += red[(k2 * 8 + b) * 64 + col];
      mod[((size_t)layer * 8 + b) * 6144 + col0 + col] = s + b_ada[(size_t)layer * 6144 + col0 + col]; }
    __syncthreads();
}

struct SsmIn { const float *a_re, *a_im, *log_dt, *b_re, *b_im, *c_re, *c_im, *d_skip; };
__device__ __forceinline__ void ssm_gen_item(int layer, int g, int half, const SsmIn& in, bf16_t* WCAT, bf16_t* WST, float* lamT, LAS unsigned char* lds, int tid) {
    LAS float* Ere = (LAS float*)lds;
    LAS float* Eim = Ere + 2 * 64 * 36;
    LAS float* Fr = Eim + 2 * 64 * 36;
    LAS float* Fi = Fr + 128;
    LAS float* BBr = Fi + 128;
    LAS float* BBi = BBr + 2 * 64 * 16;
    LAS float* Cr = BBi + 2 * 64 * 16;
    LAS float* Ci = Cr + 2 * 16 * 64;
    LAS float* Kc = Ci + 2 * 16 * 64;
    LAS float* Dsk = Kc + 64 * 260;
    {
        const int d = tid >> 8, q = tid & 255; const size_t gi = ((size_t)(layer * 2 + d) * NGRP + g) * 1024 + q * 4;
        *(LAS f32x4*)(BBr + d * 1024 + q * 4) = *(const f32x4*)(in.b_re + gi); *(LAS f32x4*)(BBi + d * 1024 + q * 4) = *(const f32x4*)(in.b_im + gi);
        *(LAS f32x4*)(Cr + d * 1024 + q * 4) = *(const f32x4*)(in.c_re + gi); *(LAS f32x4*)(Ci + d * 1024 + q * 4) = *(const f32x4*)(in.c_im + gi);
        if (tid < 16) Dsk[tid] = in.d_skip[(size_t)layer * 1024 + g * 16 + tid];
    }
    if (tid < 128) {
        const int d = tid >> 6, p = tid & 63;
        const size_t gi = ((size_t)(layer * 2 + d) * NGRP + g);
        const double dt = exp((double)in.log_dt[gi]);
        const double are = (double)in.a_re[gi * 64 + p], aim = (double)in.a_im[gi * 64 + p];
        const double mag = exp(are * dt); double ang = aim * dt;
        ang -= 6.283185307179586476925286766559 * rint(ang * 0.15915494309189533576888376337251);
        const double lr = mag * cos(ang), li = mag * sin(ang);
        const double den = are * are + aim * aim, nr = lr - 1.0, ni = li;
        Fr[tid] = (float)((nr * are + ni * aim) / den); Fi[tid] = (float)((ni * are - nr * aim) / den);
        double er = 1.0, ei = 0.0;
        for (int t = 0; t <= 32; ++t) { Ere[tid * 36 + t] = (float)er; Eim[tid * 36 + t] = (float)ei; const double tr = er * lr - ei * li, ti = er * li + ei * lr; er = tr; ei = ti; }
        if (half == 0) { lamT[((size_t)(g * 2 + d) * 64 + p) * 2 + 0] = Ere[tid * 36 + 32]; lamT[((size_t)(g * 2 + d) * 64 + p) * 2 + 1] = Eim[tid * 36 + 32]; }
    }
    __syncthreads();
    {
        const int dp = tid >> 2, sq = (tid & 3) * 4; const float fr = Fr[dp], fi = Fi[dp];
        const f32x4 br = *(const LAS f32x4*)(BBr + dp * 16 + sq), bi = *(const LAS f32x4*)(BBi + dp * 16 + sq);
        *(LAS f32x4*)(BBr + dp * 16 + sq) = fr * br - fi * bi; *(LAS f32x4*)(BBi + dp * 16 + sq) = fr * bi + fi * br;
    }
    __syncthreads();
    {
        const int d = tid >> 8, tb = (tid >> 6) & 3, sp = (tid >> 2) & 15, sb = tid & 3;
        f32x4 acc[8];
#pragma unroll
        for (int t = 0; t < 8; ++t) acc[t] = (f32x4){0.f, 0.f, 0.f, 0.f};
        for (int p = 0; p < 64; ++p) {
            const float cr = Cr[(d * 16 + sp) * 64 + p], ci = Ci[(d * 16 + sp) * 64 + p];
            const f32x4 br = *(const LAS f32x4*)(BBr + (d * 64 + p) * 16 + sb * 4), bi = *(const LAS f32x4*)(BBi + (d * 64 + p) * 16 + sb * 4);
            const f32x4 gr = cr * br - ci * bi, gim = cr * bi + ci * br;
            const f32x4 e0 = *(const LAS f32x4*)(Ere + (d * 64 + p) * 36 + tb * 8), e1 = *(const LAS f32x4*)(Ere + (d * 64 + p) * 36 + tb * 8 + 4);
            const f32x4 i0 = *(const LAS f32x4*)(Eim + (d * 64 + p) * 36 + tb * 8), i1 = *(const LAS f32x4*)(Eim + (d * 64 + p) * 36 + tb * 8 + 4);
            acc[0] += gr * e0[0] - gim * i0[0]; acc[1] += gr * e0[1] - gim * i0[1]; acc[2] += gr * e0[2] - gim * i0[2]; acc[3] += gr * e0[3] - gim * i0[3];
            acc[4] += gr * e1[0] - gim * i1[0]; acc[5] += gr * e1[1] - gim * i1[1]; acc[6] += gr * e1[2] - gim * i1[2]; acc[7] += gr * e1[3] - gim * i1[3];
        }
#pragma unroll
        for (int t = 0; t < 8; ++t) *(LAS f32x4*)(Kc + (d * 32 + tb * 8 + t) * 260 + sp * 16 + sb * 4) = acc[t];
    }
    __syncthreads();
    for (int ch = half * 256 * 96 + tid; ch < (half + 1) * 256 * 96; ch += 512) {
        const int n = ch / 96, kc = ch % 96, i = n >> 4, sp = n & 15, k0 = kc * 8;
        f32x4 va, vb;
        if (k0 < 512) {
            const int j = k0 >> 4, s0 = k0 & 15;
            if (i != j) {
                const int tau = (i > j) ? (i - j) : (32 + (j - i));
                const LAS float* src = Kc + tau * 260 + sp * 16 + s0;
                va = *(const LAS f32x4*)src; vb = *(const LAS f32x4*)(src + 4);
            } else {
                const LAS float* s0p = Kc + sp * 16 + s0; const LAS float* s1p = Kc + 32 * 260 + sp * 16 + s0;
                va = *(const LAS f32x4*)s0p + *(const LAS f32x4*)s1p; vb = *(const LAS f32x4*)(s0p + 4) + *(const LAS f32x4*)(s1p + 4);
                const int e = sp - s0;
                if (e >= 0 && e < 8) { const float dv = Dsk[sp];
                    if (e == 0) va[0] += dv; else if (e == 1) va[1] += dv; else if (e == 2) va[2] += dv; else if (e == 3) va[3] += dv;
                    else if (e == 4) vb[0] += dv; else if (e == 5) vb[1] += dv; else if (e == 6) vb[2] += dv; else vb[3] += dv; }
            }
        } else {
            const int kk = k0 - 512, d = kk >> 7, ri = (kk >> 6) & 1, p0 = kk & 63, pw = (d == 0) ? (i + 1) : (TCH - i);
            float v[8];
#pragma unroll
            for (int e = 0; e < 8; ++e) {
                const int p = p0 + e;
                const float cr = Cr[(d * 16 + sp) * 64 + p], ci = Ci[(d * 16 + sp) * 64 + p], er = Ere[(d * 64 + p) * 36 + pw], ei = Eim[(d * 64 + p) * 36 + pw];
                v[e] = (ri == 0) ? (cr * er - ci * ei) : -(cr * ei + ci * er);
            }
            va = (f32x4){v[0], v[1], v[2], v[3]}; vb = (f32x4){v[4], v[5], v[6], v[7]};
        }
        u32x4 w; w.x = cvt_pk_bf16(va[0], va[1]); w.y = cvt_pk_bf16(va[2], va[3]); w.z = cvt_pk_bf16(vb[0], vb[1]); w.w = cvt_pk_bf16(vb[2], vb[3]);
        *(u32x4*)(WCAT + ((size_t)g * 512 + n) * KA + k0) = w;
    }
    for (int ch = half * 128 * 64 + tid; ch < (half + 1) * 128 * 64; ch += 512) {
        const int n = ch >> 6, kc = ch & 63, d = n >> 7, ri = (n >> 6) & 1, p = n & 63, k0 = kc * 8, j = k0 >> 4, s0 = k0 & 15, pw = (d == 0) ? (TCH - 1 - j) : j;
        const float er = Ere[(d * 64 + p) * 36 + pw], ei = Eim[(d * 64 + p) * 36 + pw];
        const f32x4 br0 = *(const LAS f32x4*)(BBr + (d * 64 + p) * 16 + s0), br1 = *(const LAS f32x4*)(BBr + (d * 64 + p) * 16 + s0 + 4);
        const f32x4 bi0 = *(const LAS f32x4*)(BBi + (d * 64 + p) * 16 + s0), bi1 = *(const LAS f32x4*)(BBi + (d * 64 + p) * 16 + s0 + 4);
        const f32x4 va = (ri == 0) ? (er * br0 - ei * bi0) : (er * bi0 + ei * br0), vb = (ri == 0) ? (er * br1 - ei * bi1) : (er * bi1 + ei * br1);
        u32x4 w; w.x = cvt_pk_bf16(va[0], va[1]); w.y = cvt_pk_bf16(va[2], va[3]); w.z = cvt_pk_bf16(vb[0], vb[1]); w.w = cvt_pk_bf16(vb[2], vb[3]);
        *(u32x4*)(WST + ((size_t)g * 256 + n) * 512 + k0) = w;
    }
    __syncthreads();
}

__device__ __forceinline__ void s2_phase(const float* SBUF, bf16_t* ACOMB, const float* lamT, int bx, int tid) {
    if (bx >= 128) return;
    const int idx = bx * 512 + tid, p = idx & 63, d = (idx >> 6) & 1, b = (idx >> 7) & 7, g = idx >> 10;
    const float lr = lamT[((size_t)(g * 2 + d) * 64 + p) * 2], li = lamT[((size_t)(g * 2 + d) * 64 + p) * 2 + 1];
    const float* sp = SBUF + ((size_t)g * RG + b * 64) * 256 + d * 128 + p;
    bf16_t* xp = ACOMB + ((size_t)g * RG + b * 64) * KA + 512 + d * 128 + p;
    float xr = 0.f, xi = 0.f;
    for (int blk = 0; blk < 2; ++blk) {
        float sr[32], si[32];
#pragma unroll
        for (int k = 0; k < 32; ++k) { const int c = (d == 0) ? (blk * 32 + k) : (63 - (blk * 32 + k)); sr[k] = sp[(size_t)c * 256]; si[k] = sp[(size_t)c * 256 + 64]; }
#pragma unroll
        for (int k = 0; k < 32; ++k) { const int c = (d == 0) ? (blk * 32 + k) : (63 - (blk * 32 + k));
            xp[(size_t)c * KA] = (bf16_t)f2bf(xr); xp[(size_t)c * KA + 64] = (bf16_t)f2bf(xi);
            const float nr = lr * xr - li * xi + sr[k], ni = lr * xi + li * xr + si[k]; xr = nr; xi = ni; }
    }
}

__device__ __forceinline__ void norm_rows(const float* x, const float* g, const float* modl  , bf16_t* H, float* out, int mode, int gw, int NGW, int lane, bf16_t* xb = nullptr) {
    for (int row = gw; row < MTOK; row += NGW) {
        const f32x4* xr = (const f32x4*)(x + (size_t)row * DM) + lane;
        f32x4 v[8]; float ss = 0.f;
#pragma unroll
        for (int j = 0; j < 8; ++j) { v[j] = xr[64 * j]; ss += (v[j].x * v[j].x + v[j].y * v[j].y) + (v[j].z * v[j].z + v[j].w * v[j].w); }
        const float rstd = rsqrtf(wave_sum(ss) * (1.0f / DM) + EPS);
        if (mode == 0) {
            const int b = row >> 11; const float* sh = modl + (size_t)b * 6144; const float* sc = sh + 2048;
#pragma unroll
            for (int j = 0; j < 8; ++j) { const int col = 4 * lane + 256 * j; const f32x4 gg = *(const f32x4*)(g + col), s1 = *(const f32x4*)(sc + col), s0 = *(const f32x4*)(sh + col);
                const f32x4 h = v[j] * rstd * gg * (1.0f + s1) + s0; u32x2 w; w.x = cvt_pk_bf16(h.x, h.y); w.y = cvt_pk_bf16(h.z, h.w);
                *(u32x2*)(H + (size_t)row * DM + col) = w;
                if (xb) { u32x2 wx; wx.x = cvt_pk_bf16(v[j].x, v[j].y); wx.y = cvt_pk_bf16(v[j].z, v[j].w); *(u32x2*)(xb + (size_t)row * DM + col) = wx; } }
        } else {
#pragma unroll
            for (int j = 0; j < 8; ++j) { const int col = 4 * lane + 256 * j; const f32x4 gg = *(const f32x4*)(g + col); *(f32x4*)(out + (size_t)row * DM + col) = v[j] * rstd * gg; }
        }
    }
}

typedef float f32x2_t __attribute__((ext_vector_type(2)));
typedef __bf16 bf16x2_t __attribute__((ext_vector_type(2)));
__device__ __forceinline__ unsigned cvtpk_s(float lo, float hi) { f32x2_t v = {lo, hi}; bf16x2_t b = __builtin_convertvector(v, bf16x2_t); return __builtin_bit_cast(unsigned, b); }
__device__ __forceinline__ float max3f(float a, float b, float c) { float r; asm("v_max3_f32 %0, %1, %2, %3" : "=v"(r) : "v"(a), "v"(b), "v"(c)); return r; }
__device__ __forceinline__ float max2f(float a, float b) { float r; asm("v_max_f32_e32 %0, %1, %2" : "=v"(r) : "v"(a), "v"(b)); return r; }
__device__ __forceinline__ float half_max(float m) { auto rr = __builtin_amdgcn_permlane32_swap(__float_as_uint(m), __float_as_uint(m), false, false); return max2f(__uint_as_float(rr[0]), __uint_as_float(rr[1])); }
__device__ __forceinline__ float half_sum(float m) { auto rr = __builtin_amdgcn_permlane32_swap(__float_as_uint(m), __float_as_uint(m), false, false); return __uint_as_float(rr[0]) + __uint_as_float(rr[1]); }
#define ATT_SBAR() __builtin_amdgcn_sched_barrier(0)
#define ATT_MFMA(a, b, c) __builtin_amdgcn_mfma_f32_32x32x16_bf16(a, b, c, 0, 0, 0)
#define ATT_VTR(p) __builtin_amdgcn_ds_read_tr16_b64_v4i16((LAS v4i16_t*)(p))

__device__ __forceinline__ void attn_unit(LAS unsigned char* lds, const bf16_t* PROJ, bf16_t* OCAT, const float* subg, float lam, float oml, int b, int h, int qb) {
    const int tid = opaque_tid(), lane = tid & 63, r32 = lane & 31, hi = lane >> 5, wid = __builtin_amdgcn_readfirstlane(tid >> 6), comp = wid >> 2, wq = wid & 3;
    const size_t rowbase = (size_t)b * SEQ; const int q0 = qb * 128;
    bf16x8 qr[4];
    { const bf16_t* qp = PROJ + (rowbase + q0 + wq * 32 + r32) * PP + h * 128 + comp * 64 + hi * 8;
#pragma unroll
      for (int d0 = 0; d0 < 4; ++d0) qr[d0] = *(const bf16x8*)(qp + d0 * 16); }
    constexpr int KSL = 18432, VB = 2 * KSL, VSL = 20480;
    const int krow = tid >> 3, kch = tid & 7, vrow0 = tid >> 4, vch = tid & 15;
    const bf16_t* kg = PROJ + (rowbase + krow) * PP + C_K + h * 128 + kch * 8;
    const bf16_t* vg = PROJ + (rowbase + vrow0) * PP + C_V + h * 128 + vch * 8;
    const int kst = krow * 144 + kch * 16, vst = VB + vrow0 * 320 + vch * 16;
    const int rot = qb * 2;
    u32x4 ga0, ga1, ga2, ga3;
#define ATT_LOAD(S, t) do { const size_t o_ = (size_t)(((t) + rot) & 31) * 64 * PP; g##S##0 = *(const u32x4*)(kg + o_); g##S##1 = *(const u32x4*)(kg + o_ + 64); g##S##2 = *(const u32x4*)(vg + o_); g##S##3 = *(const u32x4*)(vg + o_ + (size_t)32 * PP); } while (0)
#define ATT_STORE(S, ks, vs) do { *(LAS u32x4*)(lds + (ks) + kst) = g##S##0; *(LAS u32x4*)(lds + (ks) + 9216 + kst) = g##S##1; *(LAS u32x4*)(lds + (vs) + vst) = g##S##2; *(LAS u32x4*)(lds + (vs) + vst + 32 * 320) = g##S##3; } while (0)
    const int kread = comp * 9216 + r32 * 144 + hi * 16;
    const int vread = VB + (4 * hi + ((lane & 15) >> 2)) * 320 + ((lane >> 4) & 1) * 32 + (lane & 3) * 8;
    f32x16 o[4];
#pragma unroll
    for (int i = 0; i < 4; ++i)
#pragma unroll
        for (int r = 0; r < 16; ++r) o[i][r] = 0.f;
    float mrun, lrun = 0.f;
    f32x16 pA0, pA1, pB0, pB1, negm;
    const f32x16 zero16 = {0.f, 0.f, 0.f, 0.f, 0.f, 0.f, 0.f, 0.f, 0.f, 0.f, 0.f, 0.f, 0.f, 0.f, 0.f, 0.f};

    bf16x8 kf0, kf1, kf2, kf3, kf4, kf5, kf6, kf7;
#define ATT_KRD(ks) do { const LAS unsigned char* kb_ = lds + (ks) + kread; \
        kf0 = *(const LAS bf16x8*)(kb_); kf1 = *(const LAS bf16x8*)(kb_ + 32 * 144); kf2 = *(const LAS bf16x8*)(kb_ + 32); kf3 = *(const LAS bf16x8*)(kb_ + 32 * 144 + 32); \
        kf4 = *(const LAS bf16x8*)(kb_ + 64); kf5 = *(const LAS bf16x8*)(kb_ + 32 * 144 + 64); kf6 = *(const LAS bf16x8*)(kb_ + 96); kf7 = *(const LAS bf16x8*)(kb_ + 32 * 144 + 96); } while (0)
    ATT_LOAD(a, 0); ATT_STORE(a, 0, 0); ATT_LOAD(a, 1); __syncthreads();
    {
        ATT_KRD(0);
        pA0 = ATT_MFMA(kf0, qr[0], zero16); pA1 = ATT_MFMA(kf1, qr[0], zero16);
        pA0 = ATT_MFMA(kf2, qr[1], pA0); pA1 = ATT_MFMA(kf3, qr[1], pA1);
        pA0 = ATT_MFMA(kf4, qr[2], pA0); pA1 = ATT_MFMA(kf5, qr[2], pA1);
        pA0 = ATT_MFMA(kf6, qr[3], pA0); pA1 = ATT_MFMA(kf7, qr[3], pA1);
        float mx = fmaxf(pA0[0], pA1[0]);
#pragma unroll
        for (int r = 1; r < 16; ++r) mx = fmaxf(mx, fmaxf(pA0[r], pA1[r]));
        mrun = half_max(mx);
#pragma unroll
        for (int r = 0; r < 16; ++r) { pA0[r] = __builtin_amdgcn_exp2f(pA0[r] - mrun); pA1[r] = __builtin_amdgcn_exp2f(pA1[r] - mrun); negm[r] = -mrun; }
        asm volatile("" : "+v"(negm));
    }
    ATT_STORE(a, KSL, VSL); ATT_LOAD(a, 2); __syncthreads();
    ATT_KRD(KSL);
    int vs_prev = 0, vs_store = 2 * VSL;

#define ATT_PIN(x) asm volatile("" : "+v"(x))
#define ATT_GA(MF, A0, A1, A2, A3, W0, W1, PW) do { MF; sacc += A0; sacc2 += A1; sacc += A2; sacc2 += A3; ATT_PIN(sacc); ATT_PIN(sacc2); W0; W1; ATT_PIN(PW); ATT_SBAR(); } while (0)
#define ATT_VRD(dst, ms, dvb) do { const v4i16_t lo_ = ATT_VTR(vb_ + (ms) * 16 * 320 + (dvb) * 64), hh_ = ATT_VTR(vb_ + ((ms) * 16 + 8) * 320 + (dvb) * 64); \
        dst = (bf16x8){lo_[0], lo_[1], lo_[2], lo_[3], hh_[0], hh_[1], hh_[2], hh_[3]}; } while (0)
#define ATT_GB(ms, dvb, X, j, HASN, nms) do { \
        o[dvb] = ATT_MFMA(vf##dvb, __builtin_bit_cast(bf16x8, pw##ms), o[dvb]); \
        if (HASN) ATT_VRD(vf##dvb, nms, dvb); \
        X[j] = __builtin_amdgcn_exp2f(X[j]); X[(j) + 1] = __builtin_amdgcn_exp2f(X[(j) + 1]); ATT_PIN(X); \
        if (PROBE_EXP) { float d0_, d1_; asm volatile("v_exp_f32 %0, %2\n\tv_exp_f32 %1, %3" : "=&v"(d0_), "=&v"(d1_) : "v"(X[j]), "v"(X[(j) + 1])); } \
        ATT_SBAR(); } while (0)
#define ATT_STEP(C0, C1, P0, P1, t, MORE) do { \
        if (MORE) ATT_STORE(a, (((t) + 1) & 1) * KSL, vs_store);     \
        const LAS unsigned char* vb_ = lds + vs_prev + vread; \
        u32x4 pw0, pw1, pw2, pw3; float sacc = P0[0], sacc2 = P0[1]; bf16x8 vf0, vf1, vf2, vf3; \
        ATT_SBAR(); \
        ATT_GA(C0 = ATT_MFMA(kf0, qr[0], negm), P0[2], P0[3], P0[4], P0[5],     pw0.x = cvtpk_s(P0[0], P0[1]),   pw0.y = cvtpk_s(P0[2], P0[3]), pw0); \
        ATT_GA(C1 = ATT_MFMA(kf1, qr[0], negm), P0[6], P0[7], P0[8], P0[9],     pw0.z = cvtpk_s(P0[4], P0[5]),   pw0.w = cvtpk_s(P0[6], P0[7]), pw0); \
        ATT_GA(C0 = ATT_MFMA(kf2, qr[1], C0),     P0[10], P0[11], P0[12], P0[13], pw1.x = cvtpk_s(P0[8], P0[9]),   pw1.y = cvtpk_s(P0[10], P0[11]), pw1); \
        ATT_GA(C1 = ATT_MFMA(kf3, qr[1], C1),     P0[14], P0[15], P1[0], P1[1],   pw1.z = cvtpk_s(P0[12], P0[13]), pw1.w = cvtpk_s(P0[14], P0[15]), pw1); \
        ATT_VRD(vf0, 0, 0); ATT_GA(C0 = ATT_MFMA(kf4, qr[2], C0),     P1[2], P1[3], P1[4], P1[5],     pw2.x = cvtpk_s(P1[0], P1[1]),   pw2.y = cvtpk_s(P1[2], P1[3]), pw2); \
        ATT_VRD(vf1, 0, 1); ATT_GA(C1 = ATT_MFMA(kf5, qr[2], C1),     P1[6], P1[7], P1[8], P1[9],     pw2.z = cvtpk_s(P1[4], P1[5]),   pw2.w = cvtpk_s(P1[6], P1[7]), pw2); \
        ATT_VRD(vf2, 0, 2); ATT_GA(C0 = ATT_MFMA(kf6, qr[3], C0),     P1[10], P1[11], P1[12], P1[13], pw3.x = cvtpk_s(P1[8], P1[9]),   pw3.y = cvtpk_s(P1[10], P1[11]), pw3); \
        ATT_VRD(vf3, 0, 3); ATT_GA(C1 = ATT_MFMA(kf7, qr[3], C1),     P1[14], P1[15], 0.f, 0.f,       pw3.z = cvtpk_s(P1[12], P1[13]), pw3.w = cvtpk_s(P1[14], P1[15]), pw3); \
        lrun += sacc + sacc2; \
        asm volatile("s_nop 15\n\ts_nop 7" : "+v"(C0), "+v"(C1));     \
        float mxa_ = max3f(C0[0], C0[1], C1[0]), mxb_ = max3f(C0[2], C0[3], C1[1]); mxa_ = max3f(mxa_, C1[2], C1[3]); \
        _Pragma("unroll") for (int r = 4; r < 16; r += 4) { mxa_ = max3f(mxa_, C0[r], C0[r + 1]); mxb_ = max3f(mxb_, C0[r + 2], C0[r + 3]); mxa_ = max3f(mxa_, C1[r], C1[r + 1]); mxb_ = max3f(mxb_, C1[r + 2], C1[r + 3]); } \
        float mx_ = half_max(max2f(mxa_, mxb_)); \
        float f_ = 1.0f; \
        if (__builtin_expect(__any(mx_ > 8.0f), 0)) {     \
            const float dl_ = fmaxf(mx_, 0.f); mrun += dl_; f_ = __builtin_amdgcn_exp2f(-dl_); lrun *= f_; \
            _Pragma("unroll") for (int r = 0; r < 16; ++r) { C0[r] -= dl_; C1[r] -= dl_; negm[r] = -mrun; } \
            asm volatile("" : "+v"(negm)); } \
        ATT_SBAR(); \
        if (MORE) { asm volatile("s_waitcnt lgkmcnt(0)" ::: "memory"); __builtin_amdgcn_s_barrier(); asm volatile("" ::: "memory"); \
            ATT_LOAD(a, (t) + 2); ATT_KRD((((t) + 1) & 1) * KSL); } \
        ATT_SBAR(); \
        ATT_GB(0, 0, C0, 0, true, 1);  ATT_GB(0, 1, C0, 2, true, 1);  ATT_GB(0, 2, C0, 4, true, 1);  ATT_GB(0, 3, C0, 6, true, 1); \
        ATT_GB(1, 0, C0, 8, true, 2);  ATT_GB(1, 1, C0, 10, true, 2); ATT_GB(1, 2, C0, 12, true, 2); ATT_GB(1, 3, C0, 14, true, 2); \
        ATT_GB(2, 0, C1, 0, true, 3);  ATT_GB(2, 1, C1, 2, true, 3);  ATT_GB(2, 2, C1, 4, true, 3);  ATT_GB(2, 3, C1, 6, true, 3); \
        ATT_GB(3, 0, C1, 8, false, 0); ATT_GB(3, 1, C1, 10, false, 0); ATT_GB(3, 2, C1, 12, false, 0); ATT_GB(3, 3, C1, 14, false, 0); \
        if (__any(f_ != 1.0f)) { \
            _Pragma("unroll") for (int i = 0; i < 4; ++i) _Pragma("unroll") for (int r = 0; r < 16; ++r) o[i][r] *= f_; } \
        vs_prev = (vs_prev == 3 * VSL) ? 0 : vs_prev + VSL; vs_store = (vs_store == 3 * VSL) ? 0 : vs_store + VSL; \
    } while (0)

    for (int t = 1; t < 31; t += 2) {
        ATT_STEP(pB0, pB1, pA0, pA1, t, true);
        ATT_STEP(pA0, pA1, pB0, pB1, t + 1, true);
    }
    ATT_STEP(pB0, pB1, pA0, pA1, 31, false);
    {
        float sacc = 0.f;
#pragma unroll
        for (int r = 0; r < 16; ++r) sacc += pB0[r] + pB1[r];
        lrun += sacc;
        u32x4 pw0, pw1, pw2, pw3;
        pw0.x = cvtpk_s(pB0[0], pB0[1]); pw0.y = cvtpk_s(pB0[2], pB0[3]); pw0.z = cvtpk_s(pB0[4], pB0[5]); pw0.w = cvtpk_s(pB0[6], pB0[7]);
        pw1.x = cvtpk_s(pB0[8], pB0[9]); pw1.y = cvtpk_s(pB0[10], pB0[11]); pw1.z = cvtpk_s(pB0[12], pB0[13]); pw1.w = cvtpk_s(pB0[14], pB0[15]);
        pw2.x = cvtpk_s(pB1[0], pB1[1]); pw2.y = cvtpk_s(pB1[2], pB1[3]); pw2.z = cvtpk_s(pB1[4], pB1[5]); pw2.w = cvtpk_s(pB1[6], pB1[7]);
        pw3.x = cvtpk_s(pB1[8], pB1[9]); pw3.y = cvtpk_s(pB1[10], pB1[11]); pw3.z = cvtpk_s(pB1[12], pB1[13]); pw3.w = cvtpk_s(pB1[14], pB1[15]);
        const LAS unsigned char* vb_ = lds + vs_prev + vread;
#define ATT_GD(ms, dvb) do { \
        const v4i16_t lo_ = ATT_VTR(vb_ + (ms) * 16 * 320 + (dvb) * 64), hh_ = ATT_VTR(vb_ + ((ms) * 16 + 8) * 320 + (dvb) * 64); \
        const bf16x8 vf_ = (bf16x8){lo_[0], lo_[1], lo_[2], lo_[3], hh_[0], hh_[1], hh_[2], hh_[3]}; \
        o[dvb] = ATT_MFMA(vf_, __builtin_bit_cast(bf16x8, pw##ms), o[dvb]); } while (0)
        ATT_GD(0, 0); ATT_GD(0, 1); ATT_GD(0, 2); ATT_GD(0, 3); ATT_GD(1, 0); ATT_GD(1, 1); ATT_GD(1, 2); ATT_GD(1, 3);
        ATT_GD(2, 0); ATT_GD(2, 1); ATT_GD(2, 2); ATT_GD(2, 3); ATT_GD(3, 0); ATT_GD(3, 1); ATT_GD(3, 2); ATT_GD(3, 3);
#undef ATT_GD
    }
    __syncthreads();
#undef ATT_LOAD
#undef ATT_STORE
#undef ATT_GA
#undef ATT_GB
#undef ATT_STEP
#undef ATT_KRD
#undef ATT_VRD
#undef ATT_PIN
    for (int rep_ = 0; rep_ <= PROBE_EPI; ++rep_) {
    {
        const float ltot = half_sum(lrun);
        float inv = 1.0f / ltot; if (comp == 1) inv *= lam;
        LAS float* cb = (LAS float*)lds + comp * (128 * 132) + (wq * 32 + r32) * 132 + 4 * hi;
#pragma unroll
        for (int dvb = 0; dvb < 4; ++dvb)
#pragma unroll
            for (int k4 = 0; k4 < 4; ++k4) {
                const f32x4 v = (f32x4){o[dvb][4 * k4 + 0] * inv, o[dvb][4 * k4 + 1] * inv, o[dvb][4 * k4 + 2] * inv, o[dvb][4 * k4 + 3] * inv};
                *(LAS f32x4*)(cb + dvb * 32 + 8 * k4) = v;
            }
    }
    __syncthreads();
    {
        const int q2 = tid >> 2, part = tid & 3;
        const LAS float* a0 = (const LAS float*)lds + q2 * 132 + part * 32; const LAS float* a1 = a0 + 128 * 132;
        f32x4 a[8]; float ss = 0.f;
#pragma unroll
        for (int i = 0; i < 8; ++i) { a[i] = *(const LAS f32x4*)(a0 + 4 * i) - *(const LAS f32x4*)(a1 + 4 * i); ss += (a[i].x * a[i].x + a[i].y * a[i].y) + (a[i].z * a[i].z + a[i].w * a[i].w); }
        ss += __shfl_xor(ss, 1); ss += __shfl_xor(ss, 2);
        const float rs = rsqrtf(ss * (1.0f / 128.0f) + EPS) * oml;
        const size_t row = rowbase + q0 + q2;
        const bf16_t* zp = PROJ + row * PP + C_ZA + h * 128 + part * 32; bf16_t* op = OCAT + row * 2048 + h * 128 + part * 32; const float* gp = subg + part * 32;
#pragma unroll
        for (int i = 0; i < 4; ++i) {
            const u32x4 z = *(const u32x4*)(zp + 8 * i); const f32x4 ga = *(const f32x4*)(gp + 8 * i), gb = *(const f32x4*)(gp + 8 * i + 4);
            const f32x4 xa = a[2 * i] * rs * ga, xb = a[2 * i + 1] * rs * gb;
            u32x4 w; w.x = cvt_pk_bf16(xa.x * silu_f(bflo(z.x)), xa.y * silu_f(bfhi(z.x))); w.y = cvt_pk_bf16(xa.z * silu_f(bflo(z.y)), xa.w * silu_f(bfhi(z.y)));
            w.z = cvt_pk_bf16(xb.x * silu_f(bflo(z.z)), xb.y * silu_f(bfhi(z.z))); w.w = cvt_pk_bf16(xb.z * silu_f(bflo(z.w)), xb.w * silu_f(bfhi(z.w)));
            *(u32x4*)(op + 8 * i) = w;
        }
    }
    __syncthreads();
    }
}

struct Args { const float* in[24]; float* out; unsigned char* ws; };
typedef const Args __attribute__((address_space(4)))* KArgsPtr;
__device__ __forceinline__ KArgsPtr kargs() { KArgsPtr p = (KArgsPtr)__builtin_amdgcn_kernarg_segment_ptr(); asm volatile("" : "+s"(p)); return p; }
#define WSP(T, off) ((T*)(ap->ws + (off)))

__global__ void __launch_bounds__(512, 2) fwd_megakernel(Args a_unused) {
    extern __shared__ __attribute__((aligned(16))) unsigned char lds_raw[];
    LAS unsigned char* lds = (LAS unsigned char*)lds_raw;
    cg::grid_group grid = cg::this_grid();
    const int G = gridDim.x, bx = blockIdx.x;
    const int NGW = G * 8;
#define PH_TID() const int tid = opaque_tid(), lane = tid & 63, wave = __builtin_amdgcn_readfirstlane(tid >> 6), gw = bx * 8 + wave; (void)lane; (void)gw; KArgsPtr ap = kargs()

#define XSYNC1() do { KArgsPtr ap_ = kargs(); XcdBarrier b_; b_.bar = (unsigned*)(ap_->ws + WS_BAR); b_.x = xb_xcc_id(); b_.st = (volatile LAS unsigned*)(lds + 139200); xcd_barrier(b_); } while (0)
#define GSYNC() do { XSYNC1(); if (PROBE_SYNC) XSYNC1(); } while (0)
    { if (threadIdx.x < 2) ((volatile LAS unsigned*)(lds + 139200))[threadIdx.x] = 0u; __syncthreads(); KArgsPtr ap_ = kargs(); xcd_barrier_post((unsigned*)(ap_->ws + WS_BAR)); }
    for (int r_ = 0; r_ <= (PROBE_P0 & 1); ++r_)
    { PH_TID();
      if (bx < 192) {
        LAS float* cond = (LAS float*)lds; const float* c_in = ap->in[1];
#pragma unroll 8
        for (int i = tid; i < 2048 * 8; i += 512) { const int b = i >> 11, k = i & 2047; cond[k * 8 + b] = silu_f(c_in[i]); }
        __syncthreads();
        for (int it = bx; it < 192; it += G) mod_item(it, ap->in[4], ap->in[5], WSP(float, WS_MOD), lds, tid);
      }
    }
    for (int r_ = 0; r_ <= ((PROBE_P0 >> 1) & 1); ++r_)
    { PH_TID();
      SsmIn sin_; sin_.a_re = ap->in[13]; sin_.a_im = ap->in[14]; sin_.log_dt = ap->in[15]; sin_.b_re = ap->in[16]; sin_.b_im = ap->in[17]; sin_.c_re = ap->in[18]; sin_.c_im = ap->in[19]; sin_.d_skip = ap->in[20];
      for (int it = (G - 1 - bx); it < 4 * NGRP; it += G) { const int l = it >> 7, g = (it >> 1) & 63;
          ssm_gen_item(l, g, it & 1, sin_, WSP(bf16_t, WS_WCAT) + l * WCAT_L, WSP(bf16_t, WS_WST) + l * WST_L, WSP(float, WS_LAMT) + l * LAMT_L, lds, tid); }
    }
    for (int r_ = 0; r_ <= ((PROBE_P0 >> 2) & 1); ++r_)
    { PH_TID();
        const float* w_in = ap->in[6]; const float* w_out = ap->in[7]; const float* w_glu = ap->in[21];
        bf16_t* WIN = WSP(bf16_t, WS_WIN); bf16_t* WOUT = WSP(bf16_t, WS_WOUT); bf16_t* WGLU = WSP(bf16_t, WS_WGLU);
        LAS float* scr = (LAS float*)(lds + wave * 16384);
        constexpr int I_IN = 32 * 192, I_OUT = 32 * 64, I_GLU = 16 * 64, NIT = 2 * (I_IN + I_OUT + I_GLU);
        for (int it = gw; it < NIT; it += NGW) {
            int r = it;
            if (r < 2 * I_IN) { const int l = r / I_IN, q = r % I_IN, kb = q / 192, nb = q % 192;
                transpose_item(w_in + (size_t)l * 2048 * 6144, 2048, 6144, WIN + (size_t)l * 6144 * 2048, kb * 64, nb * 32, nb * 32, scr, lane); continue; }
            r -= 2 * I_IN;
            if (r < 2 * I_OUT) { const int l = r / I_OUT, q = r % I_OUT, kb = q / 64, nb = q % 64;
                transpose_item(w_out + (size_t)l * 2048 * 2048, 2048, 2048, WOUT + (size_t)l * 2048 * 2048, kb * 64, nb * 32, nb * 32, scr, lane); continue; }
            r -= 2 * I_OUT;
            { const int l = r / I_GLU, q = r % I_GLU, kb = q / 64, nb = q % 64, n0 = nb * 32, bj = n0 >> 10, rem = n0 & 1023, pn = rem >> 7, jj = rem & 127;
              transpose_item(w_glu + (size_t)l * 1024 * 2048, 1024, 2048, WGLU + (size_t)l * 2048 * 1024, kb * 64, n0, pn * 256 + bj * 128 + jj, scr, lane); }
        }
    }
    for (int r_ = 0; r_ <= ((PROBE_P0 >> 3) & 1); ++r_)
    { PH_TID();
      const int* pos = (const int*)ap->in[2]; float* ROT = WSP(float, WS_ROT);
      for (int i = bx * 512 + tid; i < MTOK * 8; i += G * 512) {
        const int tok = i >> 3, j = i & 7;
        const float inv = exp2f(-(float)j * 0.125f * 18.931568569324174f);
        const float ang = (float)pos[tok] * inv; float s, c; sincosf(ang, &s, &c);
        ROT[(size_t)tok * 16 + j] = c; ROT[(size_t)tok * 16 + 8 + j] = s;
      }
      if (bx == 0 && wave < 2) {
        const float v1 = wave_sum(ap->in[8][wave * 64 + lane] * ap->in[9][wave * 64 + lane]), v2 = wave_sum(ap->in[10][wave * 64 + lane] * ap->in[11][wave * 64 + lane]);
        const float lam_init = 0.8f - 0.6f * expf(-0.3f * (float)wave);
        if (lane == 0) WSP(float, WS_LAMV)[wave] = expf(v1) - expf(v2) + lam_init;
      }
    }
    if (gridDim.y == 0x7fffu) grid.sync();
    GSYNC();
    { PH_TID(); norm_rows(ap->in[0], ap->in[3], WSP(float, WS_MOD), WSP(bf16_t, WS_H), nullptr, 0, gw, NGW, lane, (bf16_t*)ap->out); }
    GSYNC();

#pragma unroll 1
    for (int layer = 0; layer < 2; ++layer) {
        { KArgsPtr ap = kargs();
          pg8::StaticOrder S; S.init(MTOK, DIN, G, bx, WSP(bf16_t, WS_H), WSP(bf16_t, WS_WIN) + (size_t)layer * 6144 * 2048, DM, DM);
          EpiInProj E{ap->ws};
          for (int rep = 0; rep <= PROBE_INPROJ; ++rep) pg8::gemm_phase<INPROJ_SP2>(lds, DM, DM, DM, S, E); }
        GSYNC();
        { KArgsPtr ap = kargs();
          const int vcu = (G % 8 == 0) ? (bx % 8) * (G / 8) + bx / 8 : bx;
          pg8::GroupOrder S; S.init(NGRP, 2, 1, G, vcu, WSP(bf16_t, WS_ACOMB), WSP(bf16_t, WS_WST) + layer * WST_L, KA, 512, (size_t)RG * KA * 2, (size_t)256 * 512 * 2);
          EpiS1 E{WSP(float, WS_SBUF)};
          pg8::gemm_phase(lds, 512, KA, 512, S, E);
          if (PROBE_SSM & 1) pg8::gemm_phase(lds, 512, KA, 512, S, E); }
        GSYNC();
        for (int rep = 0; rep <= ((PROBE_SSM >> 1) & 1); ++rep) { PH_TID(); s2_phase(WSP(float, WS_SBUF), WSP(bf16_t, WS_ACOMB), WSP(float, WS_LAMT) + layer * LAMT_L, bx, tid); }
        { KArgsPtr ap = kargs();
          const int vcu = (G % 8 == 0) ? (bx % 8) * (G / 8) + bx / 8 : bx;
          const float lam = WSP(float, WS_LAMV)[layer], lam_init = 0.8f - 0.6f * expf(-0.3f * (float)layer);
          const bf16_t* PROJ = WSP(bf16_t, WS_PROJ); bf16_t* OCAT = WSP(bf16_t, WS_H); const float* subg = ap->in[12] + layer * 128;
          for (int rep = 0; rep <= PROBE_ATT; ++rep)
          for (int un = vcu; un < NB * NHEAD * 16; un += G) { const int bh = un >> 4, qb = un & 15; attn_unit(lds, PROJ, OCAT, subg, lam, 1.0f - lam_init, bh >> 3, bh & 7, qb); } }
        GSYNC();
        { KArgsPtr ap = kargs();
          const int vcu = (G % 8 == 0) ? (bx % 8) * (G / 8) + bx / 8 : bx;
          pg8::GroupOrder S; S.init(NGRP, 2, 2, G, vcu, WSP(bf16_t, WS_ACOMB), WSP(bf16_t, WS_WCAT) + layer * WCAT_L, KA, KA, (size_t)RG * KA * 2, (size_t)512 * KA * 2);
          EpiS3 E{WSP(bf16_t, WS_YG)};
          pg8::gemm_phase(lds, KA, KA, KA, S, E);
          if (PROBE_SSM & 4) pg8::gemm_phase(lds, KA, KA, KA, S, E); }
        GSYNC();
        { KArgsPtr ap = kargs();
          pg8::StaticOrder S; S.init(MTOK, 2048, G, bx, WSP(bf16_t, WS_YG), WSP(bf16_t, WS_WGLU) + (size_t)layer * 2048 * 1024, 1024, 1024);
          EpiGLU E{ap->ws, ap->in[22] + layer * 2048};
          for (int rep = 0; rep <= PROBE_GLU; ++rep) pg8::gemm_phase(lds, 1024, 1024, 1024, S, E); }
        GSYNC();
        { KArgsPtr ap = kargs();
          pg8::PanelOrder S; S.init(bx, WSP(bf16_t, WS_H), WSP(bf16_t, WS_WOUT) + (size_t)layer * 2048 * 2048, DM, DM);
          EpiOutNorm E{ap->out, WSP(float, WS_MOD) + (size_t)layer * 8 * 6144 + 4096, WSP(float, WS_RSS) + layer * 16384, WSP(unsigned, WS_CNT) + layer * 64 * 64,
                       layer == 0 ? ap->in[3] + DM : ap->in[23], WSP(float, WS_MOD) + (size_t)8 * 6144, WSP(bf16_t, WS_H), layer, ap->ws};
          pg8::gemm_phase(lds, DM, DM, DM, S, E); }
        if (layer == 0) GSYNC();
    }
}

extern "C" void kernel_launch(void* const* d_in, const int* in_sizes, int n_in, void* d_out, int out_size, void* d_ws, size_t ws_size, hipStream_t stream) {
    static int grid = 0;
    if (grid == 0) {
        if (n_in != 24 || out_size != MTOK * DM || ws_size < WS_END) { fprintf(stderr, "kernel_launch: unexpected shapes (n_in %d out %d ws %zu)\n", n_in, out_size, ws_size); grid = -1; return; }
        int dev = 0, cus = 0, per_cu = 0;
        (void)hipGetDevice(&dev);
        (void)hipDeviceGetAttribute(&cus, hipDeviceAttributeMultiprocessorCount, dev);
        (void)hipFuncSetAttribute((const void*)fwd_megakernel, hipFuncAttributeMaxDynamicSharedMemorySize, LDS_BYTES);
        (void)hipOccupancyMaxActiveBlocksPerMultiprocessor(&per_cu, (const void*)fwd_megakernel, 512, LDS_BYTES);
        if (per_cu < 1) { fprintf(stderr, "kernel_launch: occupancy query says %d blocks per CU\n", per_cu); per_cu = 1; }
        if (cus != 256) { fprintf(stderr, "kernel_launch: built for 256 CUs (got %d)\n", cus); grid = -1; return; }
        grid = cus;
    }
    if (grid < 0) return;
    (void)hipMemsetAsync((char*)d_ws + WS_BAR, 0, CTL_BYTES, stream);
    Args a{};
    for (int i = 0; i < 24; ++i) a.in[i] = (const float*)d_in[i];
    a.out = (float*)d_out; a.ws = (unsigned char*)d_ws;
    void* args[] = {&a};
    hipError_t e = hipLaunchCooperativeKernel((void*)fwd_megakernel, dim3(grid), dim3(512), args, LDS_BYTES, stream);
    if (e != hipSuccess) fprintf(stderr, "cooperative launch failed: %s (grid %d)\n", hipGetErrorString(e), grid);
}
```

```cpp
#include <hip/hip_runtime.h>
#include <hip/hip_cooperative_groups.h>
#include <cstdio>
#include <cstdint>
#include <cmath>
namespace cg = cooperative_groups;
#ifndef PROBE_SYNC
#define PROBE_SYNC 0
#endif
#ifndef PROBE_ATT
#define PROBE_ATT 0
#endif
#ifndef PROBE_INPROJ
#define PROBE_INPROJ 0
#endif
#ifndef PROBE_EPI
#define PROBE_EPI 0
#endif
#ifndef PROBE_EXP
#define PROBE_EXP 0
#endif
#ifndef INPROJ_SP2
#define INPROJ_SP2 true
#endif
#ifndef PROBE_SSM
#define PROBE_SSM 0
#endif
#ifndef PROBE_GLU
#define PROBE_GLU 0
#endif
#ifndef PROBE_P0
#define PROBE_P0 0
#endif

#define LAS __attribute__((address_space(3)))
typedef unsigned short bf16_t;
typedef short bf16x8 __attribute__((ext_vector_type(8)));
typedef short v4i16_t __attribute__((ext_vector_type(4)));
typedef float f32x4 __attribute__((ext_vector_type(4)));
typedef float f32x16 __attribute__((ext_vector_type(16)));
typedef unsigned u32x4 __attribute__((ext_vector_type(4)));
typedef unsigned u32x2 __attribute__((ext_vector_type(2)));

constexpr int NB = 8, SEQ = 2048, DM = 2048, MTOK = NB * SEQ, DIN = 6144, NHEAD = 8, NGRP = 64;
constexpr int TCH = 32, KA = TCH * 16 + 256  , RG = MTOK / TCH  ;
constexpr int PP = 5120;
constexpr int C_K = 1024, C_V = 2048, C_ZA = 3072, C_ZS = 4096;
constexpr float EPS = 1e-6f;
constexpr float QSCALE = 0.125f * 1.4426950408889634f;
constexpr int LDS_BYTES = 139264;
constexpr size_t MiB = 1u << 20;
constexpr size_t WS_MOD = 0, WS_LAMT = 512 * 1024, WS_LAMV = 768 * 1024, WS_BAR = 800 * 1024, BAR_BYTES = 16384, WS_RSS = WS_BAR + BAR_BYTES  , WS_CNT = WS_RSS + 2 * 16384 * 4  , CTL_BYTES = BAR_BYTES + 2 * 16384 * 4 + 2 * 64 * 64 * 4, WS_ROT = 1 * MiB, WS_WIN = 2 * MiB, WS_WOUT = 50 * MiB, WS_WGLU = 66 * MiB,
                 WS_WCAT = 74 * MiB, WS_WST = 170 * MiB, WS_H = 202 * MiB, WS_PROJ = 266 * MiB, WS_ACOMB = 426 * MiB, WS_SBUF = 474 * MiB, WS_YG = 474 * MiB  , WS_END = 506 * MiB;
constexpr size_t WCAT_L = (size_t)NGRP * 512 * KA, WST_L = (size_t)NGRP * 256 * 512, LAMT_L = (size_t)NGRP * 2 * 64 * 2;

__device__ __forceinline__ unsigned cvt_pk_bf16(float lo, float hi) { unsigned r; asm volatile("v_cvt_pk_bf16_f32 %0, %1, %2" : "=v"(r) : "v"(lo), "v"(hi)); return r; }
__device__ __forceinline__ unsigned f2bf(float f) { unsigned u = __builtin_bit_cast(unsigned, f); return (u + 0x7fffu + ((u >> 16) & 1u)) >> 16; }
__device__ __forceinline__ unsigned pk2(float lo, float hi) { return f2bf(lo) | (f2bf(hi) << 16); }
__device__ __forceinline__ float bflo(unsigned w) { return __uint_as_float(w << 16); }
__device__ __forceinline__ float bfhi(unsigned w) { return __uint_as_float(w & 0xffff0000u); }
__device__ __forceinline__ float wave_sum(float v) {
#pragma unroll
    for (int o = 1; o < 64; o <<= 1) v += __shfl_xor(v, o);
    return v;
}
__device__ __forceinline__ int opaque_tid() { int t = threadIdx.x; asm volatile("" : "+v"(t)); return t; }
__device__ __forceinline__ float silu_f(float z) { return z / (1.0f + __expf(-z)); }
__device__ __forceinline__ float sigmoid_f(float z) { return 1.0f / (1.0f + __expf(-z)); }
__device__ __forceinline__ float gelu_tanh_f(float y) { const float t = 0.7978845608028654f * (y + 0.044715f * y * y * y); return y * sigmoid_f(2.0f * t); }


#define XB_TMO      128
#define XB_XCNT(j)  (256  + 64 * (j))
#define XB_XSUB(j)  (1280 + 64 * (j))
#define XB_XGEN(j)  (2304 + 64 * (j))
#define XB_TOP      3328
#define XB_TOPGEN   3392
#define XCD_BAR_WORDS 3456
#define XB_SPIN_CAP (1u << 18)
__device__ __forceinline__ unsigned xb_ld(unsigned* p)              { return __hip_atomic_load(p, __ATOMIC_RELAXED, __HIP_MEMORY_SCOPE_AGENT); }
__device__ __forceinline__ unsigned xb_add(unsigned* p, unsigned v) { return __hip_atomic_fetch_add(p, v, __ATOMIC_RELAXED, __HIP_MEMORY_SCOPE_AGENT); }
__device__ __forceinline__ unsigned xb_xcc_id() { return (unsigned)__builtin_amdgcn_s_getreg((3 << 11) | 20) & 0xFu; }
#define XB_SPIN(cond, bar) do { unsigned _sp = 0; while (cond) { __builtin_amdgcn_s_sleep(1); \
    if ((++_sp & 255u) == 0u) { if (xb_ld(&(bar)[XB_TMO])) break; if (_sp > XB_SPIN_CAP) { atomicAdd(&(bar)[XB_TMO], 1u); break; } } } } while (0)
struct XcdBarrier { unsigned* bar; unsigned x; volatile LAS unsigned* st; };
__device__ __forceinline__ void xcd_barrier_post(unsigned* bar) { if (threadIdx.x == 0) (void)xb_add(&bar[XB_XCNT(xb_xcc_id())], 1u); }
__device__ __forceinline__ void xcd_barrier_complete(unsigned* bar, unsigned x, unsigned& nloc, unsigned& nx) {
    const unsigned G = gridDim.x * gridDim.y * gridDim.z;
    unsigned sum, cnt, mine, sp = 0u;
    for (;;) {
        sum = 0u; cnt = 0u; mine = 0u;
#pragma unroll
        for (unsigned j = 0; j < 16; ++j) { const unsigned c = xb_ld(&bar[XB_XCNT(j)]); sum += c; cnt += (c > 0u) ? 1u : 0u; mine = (j == x) ? c : mine; }
        if (sum == G) break;
        __builtin_amdgcn_s_sleep(1);
        if ((++sp & 255u) == 0u) { if (xb_ld(&bar[XB_TMO])) break; if (sp > XB_SPIN_CAP) { atomicAdd(&bar[XB_TMO], 1u); break; } }
    }
    nloc = mine > 0u ? mine : 1u; nx = cnt > 0u ? cnt : 1u;
}
__device__ __forceinline__ void xcd_barrier(const XcdBarrier& b) {
    asm volatile("s_waitcnt vmcnt(0)" ::: "memory");
    __syncthreads();
    if (threadIdx.x == 0) {
        unsigned* bar = b.bar;
        __builtin_amdgcn_s_waitcnt(0);
        unsigned nloc = b.st[0], nx = b.st[1];
        if (nloc == 0u) { xcd_barrier_complete(bar, b.x, nloc, nx); b.st[0] = nloc; b.st[1] = nx; }
        const unsigned old = xb_add(&bar[XB_XSUB(b.x)], 1u);
        const unsigned gen = old / nloc;
        if (old + 1u == (gen + 1u) * nloc) {
            __builtin_amdgcn_fence(__ATOMIC_RELEASE, "agent");
            asm volatile("s_waitcnt vmcnt(0)" ::: "memory");
            const unsigned og = xb_add(&bar[XB_TOP], 1u);
            const unsigned tg = og / nx;
            if (og + 1u == (tg + 1u) * nx) xb_add(&bar[XB_TOPGEN], 1u);
            else XB_SPIN(xb_ld(&bar[XB_TOPGEN]) == tg, bar);
            __builtin_amdgcn_fence(__ATOMIC_ACQUIRE, "agent");
            xb_add(&bar[XB_XGEN(b.x)], 1u);
            asm volatile("s_waitcnt vmcnt(0)" ::: "memory");
        } else {
            XB_SPIN(xb_ld(&bar[XB_XGEN(b.x)]) == gen, bar);
            __builtin_amdgcn_fence(__ATOMIC_ACQUIRE, "agent");
            asm volatile("s_waitcnt vmcnt(0)" ::: "memory");
        }
    }
    __syncthreads();
}

namespace pg8 {
constexpr int BM = 256, BK = 64, HALF = 128, HTB = HALF * BK * 2, STAGE_BYTES = 8 * HTB, NXCD = 8, WGM = 8;
__device__ __forceinline__ int lds_byte(int r, int c) { const int st = (r >> 4) * 2 + (c >> 5), rr = r & 15, cc = c & 31, ob = rr * 64 + cc * 2; return st * 1024 + (ob ^ (((ob >> 9) & 1) << 5)); }
__device__ __forceinline__ void stage_rc(int b, int& R, int& C) { const int st = b / 1024, sb = b % 1024, swz = sb ^ (((sb >> 9) & 1) << 5); R = (st >> 1) * 16 + swz / 64; C = (st & 1) * 32 + (swz % 64) / 2; }
__device__ __forceinline__ int perm32(int rho) { const int n = rho >> 4, i = rho & 15; return 8 * (i >> 2) + 4 * n + (i & 3); }

struct Unit { int pm, pn, g; const char* A; const char* B; };

struct StaticOrder {
    int nM, nN, nwg, G, c; const char* A; const char* B; unsigned tA, tB;
    __device__ void init(int M, int N, int G_, int c_, const void* A_, const void* B_, int lda, int ldb) { nM = M / BM; nN = N / BM; nwg = nM * nN; G = G_; c = c_; A = (const char*)A_; B = (const char*)B_; tA = (unsigned)(BM * lda * 2); tB = (unsigned)(BM * ldb * 2); }
    __device__ bool next(int i, Unit& u) const {
        const long L = (long)i * G + c; if (L >= nwg) return false;
        int wgid = (int)L; { const int q = nwg / NXCD, r = nwg % NXCD, xcd = wgid % NXCD, off = wgid / NXCD; wgid = (xcd < r ? xcd * (q + 1) : r * (q + 1) + (xcd - r) * q) + off; }
        const int nig = WGM * nN, gid = wgid / nig, fm = gid * WGM, gsz = (nM - fm) < WGM ? (nM - fm) : WGM;
        u.pm = fm + ((wgid % nig) % gsz); u.pn = (wgid % nig) / gsz; u.g = 0; u.A = A + (size_t)u.pm * tA; u.B = B + (size_t)u.pn * tB; return true;
    }
};
struct GroupOrder {
    int nwg, G, c, tM, tN; const char* A; const char* B; unsigned sA, sB, tA, tB;
    __device__ void init(int ngrp, int tM_, int tN_, int G_, int c_, const void* A_, const void* B_, int lda, int ldb, size_t sA_, size_t sB_) { tM = tM_; tN = tN_; nwg = ngrp * tM * tN; G = G_; c = c_; A = (const char*)A_; B = (const char*)B_; sA = (unsigned)sA_; sB = (unsigned)sB_; tA = (unsigned)(BM * lda * 2); tB = (unsigned)(BM * ldb * 2); }
    __device__ bool next(int i, Unit& u) const {
        const long L = (long)i * G + c; if (L >= nwg) return false;
        const int per = tM * tN, g = (int)L / per, r = (int)L % per; u.g = g; u.pm = r % tM; u.pn = r / tM;
        u.A = A + (size_t)g * sA + (size_t)u.pm * tA; u.B = B + (size_t)g * sB + (size_t)u.pn * tB; return true;
    }
};

struct PanelOrder {
    int c; const char* A; const char* B; unsigned tA, tB;
    __device__ void init(int c_, const void* A_, const void* B_, int lda, int ldb) { c = c_; A = (const char*)A_; B = (const char*)B_; tA = (unsigned)(BM * lda * 2); tB = (unsigned)(BM * ldb * 2); }
    __device__ bool next(int i, Unit& u) const {
        if (i >= 2) return false;
        const int x = c & 7, j = c >> 3; u.pn = j & 7; u.pm = i * 32 + x * 4 + (j >> 3); u.g = 0; u.A = A + (size_t)u.pm * tA; u.B = B + (size_t)u.pn * tB; return true;
    }
};

template <bool SP2 = true, class Epi, class Sched>
__device__ __forceinline__ void gemm_phase(LAS unsigned char* lds, const int K, const int lda, const int ldb, const Sched& S, const Epi& E) {
    const int tid = opaque_tid(), wid = __builtin_amdgcn_readfirstlane(tid >> 6), lane = tid & 63, wr = wid >> 2, wc = wid & 3, fr = lane & 15, fq = lane >> 4;
    const int nt = K / BK;
    unsigned voffA[2], voffB[2];
#pragma unroll
    for (int i = 0; i < 2; ++i) { int R, C; stage_rc(tid * 16 + i * 8192, R, C); const int Rb = (R & ~31) + perm32(R & 31);
        voffA[i] = (unsigned)(R * lda + C) * 2u; voffB[i] = (unsigned)(Rb * ldb + C) * 2u; }
    constexpr unsigned kstep = (unsigned)(BK * 2);
    const unsigned hstepA = (unsigned)(HALF * lda * 2), hstepB = (unsigned)(HALF * ldb * 2);
    const unsigned ldsw = (unsigned)wid * 1024u;
    const int aoff = lds_byte(wr * 64 + fr, fq * 8), boff = lds_byte(wc * 32 + fr, fq * 8);
#define PG8_SA(b, h) (((b) * 2 + (h)) * HTB)
#define PG8_SB(b, h) ((4 + (b) * 2 + (h)) * HTB)
#define PG8_STAGE(bufoff, gbase, voff) do { _Pragma("unroll") for (int _i = 0; _i < 2; ++_i) \
        __builtin_amdgcn_global_load_lds((const unsigned*)((const char*)(gbase) + (voff)[_i]), (LAS unsigned*)(lds + (bufoff) + ldsw + _i * 8192), 16, 0, 0); } while (0)
#define PG8_LDA(dst, b, h) do { _Pragma("unroll") for (int m = 0; m < 4; ++m) _Pragma("unroll") for (int k = 0; k < 2; ++k) dst[m][k] = *(const LAS bf16x8*)(lds + PG8_SA(b, h) + aoff + m * 2048 + k * 1024); } while (0)
#define PG8_LDB(dst, b, h) do { _Pragma("unroll") for (int n = 0; n < 2; ++n) _Pragma("unroll") for (int k = 0; k < 2; ++k) dst[n][k] = *(const LAS bf16x8*)(lds + PG8_SB(b, h) + boff + n * 2048 + k * 1024); } while (0)
#define PG8_MMA(ai, bj, At, Bt) do { __builtin_amdgcn_s_setprio(1); _Pragma("unroll") for (int m = 0; m < 4; ++m) _Pragma("unroll") for (int n = 0; n < 2; ++n) _Pragma("unroll") for (int k = 0; k < 2; ++k) \
        acc[ai][bj][m][n] = __builtin_amdgcn_mfma_f32_16x16x32_bf16(Bt[n][k], At[m][k], acc[ai][bj][m][n], 0, 0, 0); __builtin_amdgcn_s_setprio(0); } while (0)
#define PG8_WAIT_V(n) asm volatile("s_waitcnt vmcnt(" #n ")" ::: "memory")
#define PG8_WAIT_L(n) asm volatile("s_waitcnt lgkmcnt(" #n ")" ::: "memory")
#define PG8_BAR __builtin_amdgcn_s_barrier()
#define PG8_SCHED __builtin_amdgcn_sched_barrier(0)
    Unit cur, nxt; int ui = 0;
    if (!S.next(0, cur)) return;
    f32x4 acc[2][2][4][2];
#pragma unroll
    for (int a = 0; a < 2; ++a)
#pragma unroll
        for (int b = 0; b < 2; ++b)
#pragma unroll
            for (int m = 0; m < 4; ++m)
#pragma unroll
                for (int n = 0; n < 2; ++n) acc[a][b][m][n] = (f32x4){0.f, 0.f, 0.f, 0.f};
    bf16x8 At[4][2], B0[2][2], B1[2][2];
    const char* cA = cur.A; const char* cB = cur.B;
    if constexpr (SP2) {
    PG8_STAGE(PG8_SB(0, 0), cB, voffB); PG8_STAGE(PG8_SB(0, 1), cB + hstepB, voffB); PG8_STAGE(PG8_SA(0, 0), cA, voffA); PG8_STAGE(PG8_SA(0, 1), cA + hstepA, voffA);
    if (wr == 1) PG8_BAR;
    PG8_WAIT_V(2); PG8_BAR;
    PG8_STAGE(PG8_SB(1, 0), cB + kstep, voffB); PG8_STAGE(PG8_SA(1, 0), cA + kstep, voffA); PG8_STAGE(PG8_SB(1, 1), cB + hstepB + kstep, voffB);
    PG8_WAIT_V(6); PG8_BAR;
    } else {
    PG8_STAGE(PG8_SB(0, 0), cB, voffB); PG8_STAGE(PG8_SA(0, 0), cA, voffA); PG8_STAGE(PG8_SB(0, 1), cB + hstepB, voffB); PG8_STAGE(PG8_SA(0, 1), cA + hstepA, voffA);
    if (wr == 1) PG8_BAR;
    PG8_WAIT_V(4); PG8_BAR;
    PG8_STAGE(PG8_SB(1, 0), cB + kstep, voffB); PG8_STAGE(PG8_SA(1, 0), cA + kstep, voffA); PG8_STAGE(PG8_SB(1, 1), cB + hstepB + kstep, voffB);
    PG8_WAIT_V(6); PG8_BAR;
    }
    for (;;) {
        const bool has_next = S.next(ui + 1, nxt);
        const char* nA = has_next ? nxt.A : cA; const char* nB = has_next ? nxt.B : cB;
        for (int t = 0; t < nt; t += 2) {
            const bool last = (t == nt - 2);
            const char* a1 = cA + (unsigned)(t + 1) * kstep;
            const char* a2 = last ? nA : cA + (unsigned)(t + 2) * kstep; const char* b2 = last ? nB : cB + (unsigned)(t + 2) * kstep;
            const char* a3 = a2 + kstep; const char* b3 = b2 + kstep;
            if constexpr (SP2) {
            PG8_LDB(B0, 0, 0); PG8_LDB(B1, 0, 1); PG8_SCHED; PG8_LDA(At, 0, 0); PG8_STAGE(PG8_SA(1, 1), a1 + hstepA, voffA);
            PG8_WAIT_V(8); PG8_WAIT_L(0); PG8_BAR; PG8_MMA(0, 0, At, B0); PG8_MMA(0, 1, At, B1); PG8_BAR; PG8_SCHED;
            PG8_LDA(At, 0, 1); PG8_STAGE(PG8_SB(0, 0), b2, voffB); PG8_STAGE(PG8_SB(0, 1), b2 + hstepB, voffB); PG8_STAGE(PG8_SA(0, 0), a2, voffA);
            PG8_WAIT_V(8); PG8_WAIT_L(0); PG8_BAR; PG8_MMA(1, 0, At, B0); PG8_MMA(1, 1, At, B1); PG8_BAR; PG8_SCHED;
            PG8_LDB(B0, 1, 0); PG8_LDB(B1, 1, 1); PG8_SCHED; PG8_LDA(At, 1, 0); PG8_STAGE(PG8_SA(0, 1), a2 + hstepA, voffA);
            PG8_WAIT_V(8); PG8_WAIT_L(0); PG8_BAR; PG8_MMA(0, 0, At, B0); PG8_MMA(0, 1, At, B1); PG8_BAR; PG8_SCHED;
            PG8_LDA(At, 1, 1); PG8_STAGE(PG8_SB(1, 0), b3, voffB); PG8_STAGE(PG8_SB(1, 1), b3 + hstepB, voffB); PG8_STAGE(PG8_SA(1, 0), a3, voffA);
            PG8_WAIT_V(8); PG8_WAIT_L(0); PG8_BAR; PG8_MMA(1, 0, At, B0); PG8_MMA(1, 1, At, B1); PG8_BAR; PG8_SCHED;
            } else {
            PG8_LDB(B0, 0, 0); PG8_SCHED; PG8_LDA(At, 0, 0); PG8_STAGE(PG8_SA(1, 1), a1 + hstepA, voffA);
            PG8_WAIT_L(8); PG8_BAR; PG8_WAIT_L(0); PG8_MMA(0, 0, At, B0); PG8_BAR; PG8_SCHED;
            PG8_LDB(B1, 0, 1); PG8_STAGE(PG8_SB(0, 0), b2, voffB);
            PG8_BAR; PG8_WAIT_L(0); PG8_MMA(0, 1, At, B1); PG8_BAR;
            PG8_LDA(At, 0, 1); PG8_STAGE(PG8_SA(0, 0), a2, voffA);
            PG8_BAR; PG8_WAIT_L(0); PG8_MMA(1, 0, At, B0); PG8_BAR; PG8_SCHED;
            PG8_STAGE(PG8_SB(0, 1), b2 + hstepB, voffB);
            PG8_WAIT_V(6); PG8_BAR; PG8_MMA(1, 1, At, B1); PG8_BAR;
            PG8_LDB(B0, 1, 0); PG8_SCHED; PG8_LDA(At, 1, 0); PG8_STAGE(PG8_SA(0, 1), a2 + hstepA, voffA);
            PG8_WAIT_L(8); PG8_BAR; PG8_WAIT_L(0); PG8_MMA(0, 0, At, B0); PG8_BAR; PG8_SCHED;
            PG8_LDB(B1, 1, 1); PG8_STAGE(PG8_SB(1, 0), b3, voffB);
            PG8_BAR; PG8_WAIT_L(0); PG8_MMA(0, 1, At, B1); PG8_BAR;
            PG8_LDA(At, 1, 1); PG8_STAGE(PG8_SA(1, 0), a3, voffA);
            PG8_BAR; PG8_WAIT_L(0); PG8_MMA(1, 0, At, B0); PG8_BAR; PG8_SCHED;
            PG8_STAGE(PG8_SB(1, 1), b3 + hstepB, voffB);
            PG8_WAIT_V(6); PG8_BAR; PG8_MMA(1, 1, At, B1); PG8_BAR;
            }
        }
        if (wr == 0) PG8_BAR;
        if constexpr (Epi::FUSED) E.fused(acc, cur, wr, wc, fr, fq, lds, tid); else E(acc, cur, wr, wc, fr, fq);
        if (!has_next) break;
#pragma unroll
        for (int a = 0; a < 2; ++a)
#pragma unroll
            for (int b = 0; b < 2; ++b)
#pragma unroll
                for (int m = 0; m < 4; ++m)
#pragma unroll
                    for (int n = 0; n < 2; ++n) acc[a][b][m][n] = (f32x4){0.f, 0.f, 0.f, 0.f};
        cur = nxt; cA = nA; cB = nB; ++ui;
        if (wr == 1) PG8_BAR;
    }
    PG8_WAIT_V(0);
    PG8_BAR;
#undef PG8_SA
#undef PG8_SB
#undef PG8_STAGE
#undef PG8_LDA
#undef PG8_LDB
#undef PG8_MMA
#undef PG8_WAIT_V
#undef PG8_WAIT_L
#undef PG8_BAR
#undef PG8_SCHED
}
}
using pg8::Unit;
typedef f32x4 AccT[2][2][4][2];

struct EpiInProj {
    static constexpr bool FUSED = false;
    unsigned char* ws;
    __device__ __forceinline__ void operator()(const AccT& acc, const Unit& u, int wr, int wc, int fr, int fq) const {
        bf16_t* PROJ = (bf16_t*)(ws + WS_PROJ); bf16_t* ACOMB = (bf16_t*)(ws + WS_ACOMB); const float* ROT = (const float*)(ws + WS_ROT);
        const int colt = u.pn * 256, region = colt >> 10;
        if (region < 2) {
            const float qs = (region == 0) ? QSCALE : 1.0f;
            const bool rotl = ((wc & 1) == 0) && (fq < 2);
            const float sg = (fq == 0) ? -1.0f : 1.0f;
#pragma unroll
            for (int ai = 0; ai < 2; ++ai)
#pragma unroll
                for (int m = 0; m < 4; ++m) {
                    const int row = u.pm * 256 + ai * 128 + wr * 64 + m * 16 + fr;
                    const f32x4* rt = (const f32x4*)(ROT + (size_t)row * 16);
                    const f32x4 c0 = rt[0], c1 = rt[1], s0 = rt[2], s1 = rt[3];
#pragma unroll
                    for (int bj = 0; bj < 2; ++bj) {
                        const int col0 = colt + bj * 128 + wc * 32 + 8 * fq;
                        f32x4 v0 = acc[ai][bj][m][0], v1 = acc[ai][bj][m][1];
                        f32x4 p0, p1;
#pragma unroll
                        for (int e = 0; e < 4; ++e) { p0[e] = __shfl_xor(v0[e], 16); p1[e] = __shfl_xor(v1[e], 16); }
                        const f32x4 r0 = v0 * c0 + sg * (p0 * s0), r1 = v1 * c1 + sg * (p1 * s1);
                        v0 = rotl ? r0 : v0; v1 = rotl ? r1 : v1;
                        v0 = v0 * qs; v1 = v1 * qs;
                        u32x4 w; w.x = cvt_pk_bf16(v0[0], v0[1]); w.y = cvt_pk_bf16(v0[2], v0[3]); w.z = cvt_pk_bf16(v1[0], v1[1]); w.w = cvt_pk_bf16(v1[2], v1[3]);
                        *(u32x4*)(PROJ + (size_t)row * PP + col0) = w;
                    }
                    if (m & 1) asm volatile("" ::: "memory");
                }
        } else {
#pragma unroll
            for (int ai = 0; ai < 2; ++ai)
#pragma unroll
                for (int m = 0; m < 4; ++m) {
                    const int row = u.pm * 256 + ai * 128 + wr * 64 + m * 16 + fr;
#pragma unroll
                    for (int bj = 0; bj < 2; ++bj) {
                        const int col0 = colt + bj * 128 + wc * 32 + 8 * fq;
                        const f32x4 v0 = acc[ai][bj][m][0], v1 = acc[ai][bj][m][1];
                        u32x4 w; w.x = cvt_pk_bf16(v0[0], v0[1]); w.y = cvt_pk_bf16(v0[2], v0[3]); w.z = cvt_pk_bf16(v1[0], v1[1]); w.w = cvt_pk_bf16(v1[2], v1[3]);
                        if (region == 4) {
                            const int uc = col0 - 4096, g = uc >> 4, s0 = uc & 15;
                            *(u32x4*)(ACOMB + ((size_t)g * RG + (row >> 5)) * KA + (row & 31) * 16 + s0) = w;
                        } else {
                            const int pc = (region == 5) ? col0 - 1024 : col0;
                            *(u32x4*)(PROJ + (size_t)row * PP + pc) = w;
                        }
                    }
                    asm volatile("" ::: "memory");
                }
        }
    }
};
struct EpiS1 {
    static constexpr bool FUSED = false;
    float* SBUF;
    __device__ __forceinline__ void operator()(const AccT& acc, const Unit& u, int wr, int wc, int fr, int fq) const {
#pragma unroll
        for (int ai = 0; ai < 2; ++ai)
#pragma unroll
            for (int m = 0; m < 4; ++m) {
                const int row = u.pm * 256 + ai * 128 + wr * 64 + m * 16 + fr;
                float* rp = SBUF + ((size_t)u.g * RG + row) * 256 + u.pn * 256 + wc * 32 + 8 * fq;
#pragma unroll
                for (int bj = 0; bj < 2; ++bj) { *(f32x4*)(rp + bj * 128) = acc[ai][bj][m][0]; *(f32x4*)(rp + bj * 128 + 4) = acc[ai][bj][m][1]; }
            }
    }
};
struct EpiS3 {
    static constexpr bool FUSED = false;
    bf16_t* YG;
    __device__ __forceinline__ void operator()(const AccT& acc, const Unit& u, int wr, int wc, int fr, int fq) const {
#pragma unroll
        for (int ai = 0; ai < 2; ++ai)
#pragma unroll
            for (int m = 0; m < 4; ++m) {
                const int rg = u.pm * 256 + ai * 128 + wr * 64 + m * 16 + fr;
#pragma unroll
                for (int bj = 0; bj < 2; ++bj) {
                    const int nc = u.pn * 256 + bj * 128 + wc * 32 + 8 * fq, i = nc >> 4, s0 = nc & 15;
                    const f32x4 v0 = acc[ai][bj][m][0], v1 = acc[ai][bj][m][1];
                    u32x4 w; w.x = cvt_pk_bf16(gelu_tanh_f(v0[0]), gelu_tanh_f(v0[1])); w.y = cvt_pk_bf16(gelu_tanh_f(v0[2]), gelu_tanh_f(v0[3]));
                    w.z = cvt_pk_bf16(gelu_tanh_f(v1[0]), gelu_tanh_f(v1[1])); w.w = cvt_pk_bf16(gelu_tanh_f(v1[2]), gelu_tanh_f(v1[3]));
                    *(u32x4*)(YG + ((size_t)rg * 32 + i) * 1024 + u.g * 16 + s0) = w;
                }
            }
    }
};
struct EpiGLU {
    static constexpr bool FUSED = false;
    unsigned char* ws; const float* bglu;
    __device__ __forceinline__ void operator()(const AccT& acc, const Unit& u, int wr, int wc, int fr, int fq) const {
        bf16_t* OCAT = (bf16_t*)(ws + WS_H); const bf16_t* PROJ = (const bf16_t*)(ws + WS_PROJ);
        const int lc = u.pn * 128 + wc * 32 + 8 * fq;
        const f32x4 bl0 = *(const f32x4*)(bglu + lc), bl1 = *(const f32x4*)(bglu + lc + 4), bg0 = *(const f32x4*)(bglu + 1024 + lc), bg1 = *(const f32x4*)(bglu + 1024 + lc + 4);
#pragma unroll
        for (int ai = 0; ai < 2; ++ai)
#pragma unroll
            for (int m = 0; m < 4; ++m) {
                const int row = u.pm * 256 + ai * 128 + wr * 64 + m * 16 + fr;
                const u32x4 z = *(const u32x4*)(PROJ + (size_t)row * PP + C_ZS + lc);
                const f32x4 l0 = acc[ai][0][m][0] + bl0, l1 = acc[ai][0][m][1] + bl1, g0 = acc[ai][1][m][0] + bg0, g1 = acc[ai][1][m][1] + bg1;
                float o[8];
                o[0] = l0[0] * sigmoid_f(g0[0]) * silu_f(bflo(z.x)); o[1] = l0[1] * sigmoid_f(g0[1]) * silu_f(bfhi(z.x));
                o[2] = l0[2] * sigmoid_f(g0[2]) * silu_f(bflo(z.y)); o[3] = l0[3] * sigmoid_f(g0[3]) * silu_f(bfhi(z.y));
                o[4] = l1[0] * sigmoid_f(g1[0]) * silu_f(bflo(z.z)); o[5] = l1[1] * sigmoid_f(g1[1]) * silu_f(bfhi(z.z));
                o[6] = l1[2] * sigmoid_f(g1[2]) * silu_f(bflo(z.w)); o[7] = l1[3] * sigmoid_f(g1[3]) * silu_f(bfhi(z.w));
                u32x4 w; w.x = cvt_pk_bf16(o[0], o[1]); w.y = cvt_pk_bf16(o[2], o[3]); w.z = cvt_pk_bf16(o[4], o[5]); w.w = cvt_pk_bf16(o[6], o[7]);
                *(u32x4*)(OCAT + (size_t)row * 2048 + 1024 + lc) = w;
                if (m == 3) asm volatile("" ::: "memory");
            }
    }
};
struct EpiOut {
    static constexpr bool FUSED = false;
    const float* xold; float* xnew; const float* gate;
    __device__ __forceinline__ void operator()(const AccT& acc, const Unit& u, int wr, int wc, int fr, int fq) const {
        const int bb = u.pm >> 3;
#pragma unroll
        for (int bj = 0; bj < 2; ++bj) {
            const int col0 = u.pn * 256 + bj * 128 + wc * 32 + 8 * fq;
            const f32x4 gt0 = *(const f32x4*)(gate + (size_t)bb * 6144 + col0), gt1 = *(const f32x4*)(gate + (size_t)bb * 6144 + col0 + 4);
#pragma unroll
            for (int ai = 0; ai < 2; ++ai)
#pragma unroll
                for (int m = 0; m < 4; ++m) {
                    const size_t off = (size_t)(u.pm * 256 + ai * 128 + wr * 64 + m * 16 + fr) * DM + col0;
                    const f32x4 x0 = *(const f32x4*)(xold + off), x1 = *(const f32x4*)(xold + off + 4);
                    *(f32x4*)(xnew + off) = x0 + gt0 * acc[ai][bj][m][0]; *(f32x4*)(xnew + off + 4) = x1 + gt1 * acc[ai][bj][m][1];
                    asm volatile("" ::: "memory");
                }
        }
    }
};

struct EpiOutNorm {
    static constexpr bool FUSED = true;
    float* OUT; const float* gate; float* rss; unsigned* cnt; const float* g; const float* modn; bf16_t* H; int mode; unsigned char* ws;
    __device__ __forceinline__ bf16_t* x1base(const Unit& u) const { return (bf16_t*)(ws + (u.pm < 48 ? WS_WCAT : WS_WST - (size_t)12288 * 4096)); }
    __device__ __forceinline__ void fused(AccT& acc, const Unit& u, int wr, int wc, int fr, int fq, LAS unsigned char* lds, int tid_unused) const {
        const int tid = opaque_tid();
        LAS float* P = (LAS float*)(lds + 131072);
        LAS float* S = (LAS float*)(lds + 131072 + 4096);
        const int bb = u.pm >> 3;
        bf16_t* const x1b = x1base(u); const bf16_t* const resb = (mode == 0) ? (const bf16_t*)OUT : (const bf16_t*)x1b;
        float ss[2][4];
#pragma unroll
        for (int ai = 0; ai < 2; ++ai)
#pragma unroll
            for (int m = 0; m < 4; ++m) ss[ai][m] = 0.f;
#pragma unroll
        for (int bj = 0; bj < 2; ++bj) {
            const int col0 = u.pn * 256 + bj * 128 + wc * 32 + 8 * fq;
            const f32x4 gt0 = *(const f32x4*)(gate + (size_t)bb * 6144 + col0), gt1 = *(const f32x4*)(gate + (size_t)bb * 6144 + col0 + 4);
#pragma unroll
            for (int ai = 0; ai < 2; ++ai) {
#pragma unroll
                for (int m = 0; m < 4; ++m) {
                    const int row_ = u.pm * 256 + ai * 128 + wr * 64 + m * 16 + fr;
                    const u32x4 xb = *(const u32x4*)(resb + (size_t)row_ * DM + col0);
                    const f32x4 x0 = (f32x4){bflo(xb.x), bfhi(xb.x), bflo(xb.y), bfhi(xb.y)}, x1 = (f32x4){bflo(xb.z), bfhi(xb.z), bflo(xb.w), bfhi(xb.w)};
                    const f32x4 v0 = x0 + gt0 * acc[ai][bj][m][0], v1 = x1 + gt1 * acc[ai][bj][m][1];
                    acc[ai][bj][m][0] = v0; acc[ai][bj][m][1] = v1;
                    ss[ai][m] += (v0[0] * v0[0] + v0[1] * v0[1]) + (v0[2] * v0[2] + v0[3] * v0[3]) + (v1[0] * v1[0] + v1[1] * v1[1]) + (v1[2] * v1[2] + v1[3] * v1[3]);
                    if (m & 1) asm volatile("" ::: "memory");
                }
            }
        }
#pragma unroll
        for (int ai = 0; ai < 2; ++ai)
#pragma unroll
            for (int m = 0; m < 4; ++m) { float v = ss[ai][m]; v += __shfl_xor(v, 16); v += __shfl_xor(v, 32); if (fq == 0) P[(ai * 128 + wr * 64 + m * 16 + fr) * 4 + wc] = v; }
        asm volatile("s_waitcnt lgkmcnt(0)" ::: "memory"); __builtin_amdgcn_s_barrier(); asm volatile("" ::: "memory");
        if (tid < 256) { const f32x4 p = *(const LAS f32x4*)(P + tid * 4);
            (void)__hip_atomic_fetch_add(rss + u.pm * 256 + tid, (p[0] + p[1]) + (p[2] + p[3]), __ATOMIC_RELAXED, __HIP_MEMORY_SCOPE_AGENT); }
        asm volatile("s_waitcnt vmcnt(0)" ::: "memory"); __builtin_amdgcn_s_barrier(); asm volatile("" ::: "memory");
        if (tid < 64) {
            if (tid == 0) (void)__hip_atomic_fetch_add(cnt + u.pm * 64, 1u, __ATOMIC_RELAXED, __HIP_MEMORY_SCOPE_AGENT);
            unsigned sp = 0;
            while ((unsigned)__builtin_amdgcn_readfirstlane(__hip_atomic_load(cnt + u.pm * 64, __ATOMIC_RELAXED, __HIP_MEMORY_SCOPE_AGENT)) < 8u) { __builtin_amdgcn_s_sleep(2); if (++sp > (1u << 22)) break; }
        }
        asm volatile("s_waitcnt vmcnt(0) lgkmcnt(0)" ::: "memory"); __builtin_amdgcn_s_barrier(); asm volatile("" ::: "memory");
        if (tid < 256) { const float t = __hip_atomic_load(rss + u.pm * 256 + tid, __ATOMIC_RELAXED, __HIP_MEMORY_SCOPE_AGENT); S[tid] = rsqrtf(t * (1.0f / DM) + EPS); }
        asm volatile("s_waitcnt vmcnt(0) lgkmcnt(0)" ::: "memory"); __builtin_amdgcn_s_barrier(); asm volatile("" ::: "memory");
#pragma unroll
        for (int bj = 0; bj < 2; ++bj) {
            const int col0 = u.pn * 256 + bj * 128 + wc * 32 + 8 * fq;
            f32x4 w0 = *(const f32x4*)(g + col0), w1 = *(const f32x4*)(g + col0 + 4), a0 = {0.f, 0.f, 0.f, 0.f}, a1 = a0;
            if (mode == 0) { const float* sh = modn + (size_t)bb * 6144; a0 = *(const f32x4*)(sh + col0); a1 = *(const f32x4*)(sh + col0 + 4);
                w0 = w0 * (1.0f + *(const f32x4*)(sh + 2048 + col0)); w1 = w1 * (1.0f + *(const f32x4*)(sh + 2048 + col0 + 4)); }
#pragma unroll
            for (int ai = 0; ai < 2; ++ai)
#pragma unroll
                for (int m = 0; m < 4; ++m) {
                    const int r = ai * 128 + wr * 64 + m * 16 + fr; const float rs = S[r];
                    const size_t off = (size_t)(u.pm * 256 + r) * DM + col0;
                    const f32x4 v0 = acc[ai][bj][m][0], v1 = acc[ai][bj][m][1];
                    const f32x4 o0 = v0 * rs * w0 + a0, o1 = v1 * rs * w1 + a1;
                    if (mode == 0) {
                        u32x4 xw; xw.x = cvt_pk_bf16(v0[0], v0[1]); xw.y = cvt_pk_bf16(v0[2], v0[3]); xw.z = cvt_pk_bf16(v1[0], v1[1]); xw.w = cvt_pk_bf16(v1[2], v1[3]); *(u32x4*)(x1b + off) = xw;
                        u32x4 w; w.x = cvt_pk_bf16(o0[0], o0[1]); w.y = cvt_pk_bf16(o0[2], o0[3]); w.z = cvt_pk_bf16(o1[0], o1[1]); w.w = cvt_pk_bf16(o1[2], o1[3]); *(u32x4*)(H + off) = w;
                    } else { *(f32x4*)(OUT + off) = o0; *(f32x4*)(OUT + off + 4) = o1; }
                    asm volatile("" ::: "memory");
                }
        }
        asm volatile("s_waitcnt lgkmcnt(0)" ::: "memory"); __builtin_amdgcn_s_barrier(); asm volatile("" ::: "memory");
    }
};

__device__ __forceinline__ void transpose_item(const float* W, int K, int N, bf16_t* WT, int k0, int n0, int rowbase, LAS float* scr, int lane) {
#pragma unroll
    for (int i = 0; i < 32; ++i) { const int kk = 2 * i + (lane >> 5); scr[kk * 33 + (lane & 31)] = W[(size_t)(k0 + kk) * N + n0 + (lane & 31)]; }
    asm volatile("s_waitcnt lgkmcnt(0)" ::: "memory");
    const int c = lane & 7;
#pragma unroll
    for (int j = 0; j < 4; ++j) { const int n = (lane >> 3) + 8 * j; const LAS float* s = scr + (8 * c) * 33 + n;
        u32x4 o; o.x = pk2(s[0 * 33], s[1 * 33]); o.y = pk2(s[2 * 33], s[3 * 33]); o.z = pk2(s[4 * 33], s[5 * 33]); o.w = pk2(s[6 * 33], s[7 * 33]);
        *(u32x4*)(WT + (size_t)(rowbase + n) * K + k0 + 8 * c) = o; }
    asm volatile("s_waitcnt lgkmcnt(0)" ::: "memory");
}

__device__ __forceinline__ void mod_item(int item, const float* w_ada, const float* b_ada, float* mod, LAS unsigned char* lds, int tid) {
    const int layer = item / 96, col0 = (item % 96) * 64, quad = tid & 15, ks = tid >> 4;
    const LAS float* cond = (const LAS float*)lds; LAS float* red = (LAS float*)(lds + 65536);
    const float* wp = w_ada + ((size_t)layer * 2048 + ks * 64) * 6144 + col0 + quad * 4;
    f32x4 a0 = {0, 0, 0, 0}, a1 = a0, a2 = a0, a3 = a0, a4 = a0, a5 = a0, a6 = a0, a7 = a0;
#pragma unroll 8
    for (int kk = 0; kk < 64; ++kk) {
        const f32x4 w = *(const f32x4*)(wp + (size_t)kk * 6144);
        const f32x4 c0 = *(const LAS f32x4*)(cond + (ks * 64 + kk) * 8), c1 = *(const LAS f32x4*)(cond + (ks * 64 + kk) * 8 + 4);
        a0 += c0[0] * w; a1 += c0[1] * w; a2 += c0[2] * w; a3 += c0[3] * w; a4 += c1[0] * w; a5 += c1[1] * w; a6 += c1[2] * w; a7 += c1[3] * w;
    }
    LAS float* rp = red + (ks * 8) * 64 + quad * 4;
    *(LAS f32x4*)(rp + 0 * 64) = a0; *(LAS f32x4*)(rp + 1 * 64) = a1; *(LAS f32x4*)(rp + 2 * 64) = a2; *(LAS f32x4*)(rp + 3 * 64) = a3;
    *(LAS f32x4*)(rp + 4 * 64) = a4; *(LAS f32x4*)(rp + 5 * 64) = a5; *(LAS f32x4*)(rp + 6 * 64) = a6; *(LAS f32x4*)(rp + 7 * 64) = a7;
    __syncthreads();
    { const int b = tid >> 6, col = tid & 63; float s = 0.f;
#pragma unroll 8
      for (int k2 = 0; k2 < 32; ++k2) s += red[(k2 * 8 + b) * 64 + col];
      mod[((size_t)layer * 8 + b) * 6144 + col0 + col] = s + b_ada[(size_t)layer * 6144 + col0 + col]; }
    __syncthreads();
}

struct SsmIn { const float *a_re, *a_im, *log_dt, *b_re, *b_im, *c_re, *c_im, *d_skip; };
__device__ __forceinline__ void ssm_gen_item(int layer, int g, int half, const SsmIn& in, bf16_t* WCAT, bf16_t* WST, float* lamT, LAS unsigned char* lds, int tid) {
    LAS float* Ere = (LAS float*)lds;
    LAS float* Eim = Ere + 2 * 64 * 36;
    LAS float* Fr = Eim + 2 * 64 * 36;
    LAS float* Fi = Fr + 128;
    LAS float* BBr = Fi + 128;
    LAS float* BBi = BBr + 2 * 64 * 16;
    LAS float* Cr = BBi + 2 * 64 * 16;
    LAS float* Ci = Cr + 2 * 16 * 64;
    LAS float* Kc = Ci + 2 * 16 * 64;
    LAS float* Dsk = Kc + 64 * 260;
    {
        const int d = tid >> 8, q = tid & 255; const size_t gi = ((size_t)(layer * 2 + d) * NGRP + g) * 1024 + q * 4;
        *(LAS f32x4*)(BBr + d * 1024 + q * 4) = *(const f32x4*)(in.b_re + gi); *(LAS f32x4*)(BBi + d * 1024 + q * 4) = *(const f32x4*)(in.b_im + gi);
        *(LAS f32x4*)(Cr + d * 1024 + q * 4) = *(const f32x4*)(in.c_re + gi); *(LAS f32x4*)(Ci + d * 1024 + q * 4) = *(const f32x4*)(in.c_im + gi);
        if (tid < 16) Dsk[tid] = in.d_skip[(size_t)layer * 1024 + g * 16 + tid];
    }
    if (tid < 128) {
        const int d = tid >> 6, p = tid & 63;
        const size_t gi = ((size_t)(layer * 2 + d) * NGRP + g);
        const double dt = exp((double)in.log_dt[gi]);
        const double are = (double)in.a_re[gi * 64 + p], aim = (double)in.a_im[gi * 64 + p];
        const double mag = exp(are * dt); double ang = aim * dt;
        ang -= 6.283185307179586476925286766559 * rint(ang * 0.15915494309189533576888376337251);
        const double lr = mag * cos(ang), li = mag * sin(ang);
        const double den = are * are + aim * aim, nr = lr - 1.0, ni = li;
        Fr[tid] = (float)((nr * are + ni * aim) / den); Fi[tid] = (float)((ni * are - nr * aim) / den);
        double er = 1.0, ei = 0.0;
        for (int t = 0; t <= 32; ++t) { Ere[tid * 36 + t] = (float)er; Eim[tid * 36 + t] = (float)ei; const double tr = er * lr - ei * li, ti = er * li + ei * lr; er = tr; ei = ti; }
        if (half == 0) { lamT[((size_t)(g * 2 + d) * 64 + p) * 2 + 0] = Ere[tid * 36 + 32]; lamT[((size_t)(g * 2 + d) * 64 + p) * 2 + 1] = Eim[tid * 36 + 32]; }
    }
    __syncthreads();
    {
        const int dp = tid >> 2, sq = (tid & 3) * 4; const float fr = Fr[dp], fi = Fi[dp];
        const f32x4 br = *(const LAS f32x4*)(BBr + dp * 16 + sq), bi = *(const LAS f32x4*)(BBi + dp * 16 + sq);
        *(LAS f32x4*)(BBr + dp * 16 + sq) = fr * br - fi * bi; *(LAS f32x4*)(BBi + dp * 16 + sq) = fr * bi + fi * br;
    }
    __syncthreads();
    {
        const int d = tid >> 8, tb = (tid >> 6) & 3, sp = (tid >> 2) & 15, sb = tid & 3;
        f32x4 acc[8];
#pragma unroll
        for (int t = 0; t < 8; ++t) acc[t] = (f32x4){0.f, 0.f, 0.f, 0.f};
        for (int p = 0; p < 64; ++p) {
            const float cr = Cr[(d * 16 + sp) * 64 + p], ci = Ci[(d * 16 + sp) * 64 + p];
            const f32x4 br = *(const LAS f32x4*)(BBr + (d * 64 + p) * 16 + sb * 4), bi = *(const LAS f32x4*)(BBi + (d * 64 + p) * 16 + sb * 4);
            const f32x4 gr = cr * br - ci * bi, gim = cr * bi + ci * br;
            const f32x4 e0 = *(const LAS f32x4*)(Ere + (d * 64 + p) * 36 + tb * 8), e1 = *(const LAS f32x4*)(Ere + (d * 64 + p) * 36 + tb * 8 + 4);
            const f32x4 i0 = *(const LAS f32x4*)(Eim + (d * 64 + p) * 36 + tb * 8), i1 = *(const LAS f32x4*)(Eim + (d * 64 + p) * 36 + tb * 8 + 4);
            acc[0] += gr * e0[0] - gim * i0[0]; acc[1] += gr * e0[1] - gim * i0[1]; acc[2] += gr * e0[2] - gim * i0[2]; acc[3] += gr * e0[3] - gim * i0[3];
            acc[4] += gr * e1[0] - gim * i1[0]; acc[5] += gr * e1[1] - gim * i1[1]; acc[6] += gr * e1[2] - gim * i1[2]; acc[7] += gr * e1[3] - gim * i1[3];
        }
#pragma unroll
        for (int t = 0; t < 8; ++t) *(LAS f32x4*)(Kc + (d * 32 + tb * 8 + t) * 260 + sp * 16 + sb * 4) = acc[t];
    }
    __syncthreads();
    for (int ch = half * 256 * 96 + tid; ch < (half + 1) * 256 * 96; ch += 512) {
        const int n = ch / 96, kc = ch % 96, i = n >> 4, sp = n & 15, k0 = kc * 8;
        f32x4 va, vb;
        if (k0 < 512) {
            const int j = k0 >> 4, s0 = k0 & 15;
            if (i != j) {
                const int tau = (i > j) ? (i - j) : (32 + (j - i));
                const LAS float* src = Kc + tau * 260 + sp * 16 + s0;
                va = *(const LAS f32x4*)src; vb = *(const LAS f32x4*)(src + 4);
            } else {
                const LAS float* s0p = Kc + sp * 16 + s0; const LAS float* s1p = Kc + 32 * 260 + sp * 16 + s0;
                va = *(const LAS f32x4*)s0p + *(const LAS f32x4*)s1p; vb = *(const LAS f32x4*)(s0p + 4) + *(const LAS f32x4*)(s1p + 4);
                const int e = sp - s0;
                if (e >= 0 && e < 8) { const float dv = Dsk[sp];
                    if (e == 0) va[0] += dv; else if (e == 1) va[1] += dv; else if (e == 2) va[2] += dv; else if (e == 3) va[3] += dv;
                    else if (e == 4) vb[0] += dv; else if (e == 5) vb[1] += dv; else if (e == 6) vb[2] += dv; else vb[3] += dv; }
            }
        } else {
            const int kk = k0 - 512, d = kk >> 7, ri = (kk >> 6) & 1, p0 = kk & 63, pw = (d == 0) ? (i + 1) : (TCH - i);
            float v[8];
#pragma unroll
            for (int e = 0; e < 8; ++e) {
                const int p = p0 + e;
                const float cr = Cr[(d * 16 + sp) * 64 + p], ci = Ci[(d * 16 + sp) * 64 + p], er = Ere[(d * 64 + p) * 36 + pw], ei = Eim[(d * 64 + p) * 36 + pw];
                v[e] = (ri == 0) ? (cr * er - ci * ei) : -(cr * ei + ci * er);
            }
            va = (f32x4){v[0], v[1], v[2], v[3]}; vb = (f32x4){v[4], v[5], v[6], v[7]};
        }
        u32x4 w; w.x = cvt_pk_bf16(va[0], va[1]); w.y = cvt_pk_bf16(va[2], va[3]); w.z = cvt_pk_bf16(vb[0], vb[1]); w.w = cvt_pk_bf16(vb[2], vb[3]);
        *(u32x4*)(WCAT + ((size_t)g * 512 + n) * KA + k0) = w;
    }
    for (int ch = half * 128 * 64 + tid; ch < (half + 1) * 128 * 64; ch += 512) {
        const int n = ch >> 6, kc = ch & 63, d = n >> 7, ri = (n >> 6) & 1, p = n & 63, k0 = kc * 8, j = k0 >> 4, s0 = k0 & 15, pw = (d == 0) ? (TCH - 1 - j) : j;
        const float er = Ere[(d * 64 + p) * 36 + pw], ei = Eim[(d * 64 + p) * 36 + pw];
        const f32x4 br0 = *(const LAS f32x4*)(BBr + (d * 64 + p) * 16 + s0), br1 = *(const LAS f32x4*)(BBr + (d * 64 + p) * 16 + s0 + 4);
        const f32x4 bi0 = *(const LAS f32x4*)(BBi + (d * 64 + p) * 16 + s0), bi1 = *(const LAS f32x4*)(BBi + (d * 64 + p) * 16 + s0 + 4);
        const f32x4 va = (ri == 0) ? (er * br0 - ei * bi0) : (er * bi0 + ei * br0), vb = (ri == 0) ? (er * br1 - ei * bi1) : (er * bi1 + ei * br1);
        u32x4 w; w.x = cvt_pk_bf16(va[0], va[1]); w.y = cvt_pk_bf16(va[2], va[3]); w.z = cvt_pk_bf16(vb[0], vb[1]); w.w = cvt_pk_bf16(vb[2], vb[3]);
        *(u32x4*)(WST + ((size_t)g * 256 + n) * 512 + k0) = w;
    }
    __syncthreads();
}

__device__ __forceinline__ void s2_phase(const float* SBUF, bf16_t* ACOMB, const float* lamT, int bx, int tid) {
    if (bx >= 128) return;
    const int idx = bx * 512 + tid, p = idx & 63, d = (idx >> 6) & 1, b = (idx >> 7) & 7, g = idx >> 10;
    const float lr = lamT[((size_t)(g * 2 + d) * 64 + p) * 2], li = lamT[((size_t)(g * 2 + d) * 64 + p) * 2 + 1];
    const float* sp = SBUF + ((size_t)g * RG + b * 64) * 256 + d * 128 + p;
    bf16_t* xp = ACOMB + ((size_t)g * RG + b * 64) * KA + 512 + d * 128 + p;
    float xr = 0.f, xi = 0.f;
    for (int blk = 0; blk < 2; ++blk) {
        float sr[32], si[32];
#pragma unroll
        for (int k = 0; k < 32; ++k) { const int c = (d == 0) ? (blk * 32 + k) : (63 - (blk * 32 + k)); sr[k] = sp[(size_t)c * 256]; si[k] = sp[(size_t)c * 256 + 64]; }
#pragma unroll
        for (int k = 0; k < 32; ++k) { const int c = (d == 0) ? (blk * 32 + k) : (63 - (blk * 32 + k));
            xp[(size_t)c * KA] = (bf16_t)f2bf(xr); xp[(size_t)c * KA + 64] = (bf16_t)f2bf(xi);
            const float nr = lr * xr - li * xi + sr[k], ni = lr * xi + li * xr + si[k]; xr = nr; xi = ni; }
    }
}

__device__ __forceinline__ void norm_rows(const float* x, const float* g, const float* modl  , bf16_t* H, float* out, int mode, int gw, int NGW, int lane, bf16_t* xb = nullptr) {
    for (int row = gw; row < MTOK; row += NGW) {
        const f32x4* xr = (const f32x4*)(x + (size_t)row * DM) + lane;
        f32x4 v[8]; float ss = 0.f;
#pragma unroll
        for (int j = 0; j < 8; ++j) { v[j] = xr[64 * j]; ss += (v[j].x * v[j].x + v[j].y * v[j].y) + (v[j].z * v[j].z + v[j].w * v[j].w); }
        const float rstd = rsqrtf(wave_sum(ss) * (1.0f / DM) + EPS);
        if (mode == 0) {
            const int b = row >> 11; const float* sh = modl + (size_t)b * 6144; const float* sc = sh + 2048;
#pragma unroll
            for (int j = 0; j < 8; ++j) { const int col = 4 * lane + 256 * j; const f32x4 gg = *(const f32x4*)(g + col), s1 = *(const f32x4*)(sc + col), s0 = *(const f32x4*)(sh + col);
                const f32x4 h = v[j] * rstd * gg * (1.0f + s1) + s0; u32x2 w; w.x = cvt_pk_bf16(h.x, h.y); w.y = cvt_pk_bf16(h.z, h.w);
                *(u32x2*)(H + (size_t)row * DM + col) = w;
                if (xb) { u32x2 wx; wx.x = cvt_pk_bf16(v[j].x, v[j].y); wx.y = cvt_pk_bf16(v[j].z, v[j].w); *(u32x2*)(xb + (size_t)row * DM + col) = wx; } }
        } else {
#pragma unroll
            for (int j = 0; j < 8; ++j) { const int col = 4 * lane + 256 * j; const f32x4 gg = *(const f32x4*)(g + col); *(f32x4*)(out + (size_t)row * DM + col) = v[j] * rstd * gg; }
        }
    }
}

typedef float f32x2_t __attribute__((ext_vector_type(2)));
typedef __bf16 bf16x2_t __attribute__((ext_vector_type(2)));
__device__ __forceinline__ unsigned cvtpk_s(float lo, float hi) { f32x2_t v = {lo, hi}; bf16x2_t b = __builtin_convertvector(v, bf16x2_t); return __builtin_bit_cast(unsigned, b); }
__device__ __forceinline__ float max3f(float a, float b, float c) { float r; asm("v_max3_f32 %0, %1, %2, %3" : "=v"(r) : "v"(a), "v"(b), "v"(c)); return r; }
__device__ __forceinline__ float max2f(float a, float b) { float r; asm("v_max_f32_e32 %0, %1, %2" : "=v"(r) : "v"(a), "v"(b)); return r; }
__device__ __forceinline__ float half_max(float m) { auto rr = __builtin_amdgcn_permlane32_swap(__float_as_uint(m), __float_as_uint(m), false, false); return max2f(__uint_as_float(rr[0]), __uint_as_float(rr[1])); }
__device__ __forceinline__ float half_sum(float m) { auto rr = __builtin_amdgcn_permlane32_swap(__float_as_uint(m), __float_as_uint(m), false, false); return __uint_as_float(rr[0]) + __uint_as_float(rr[1]); }
#define ATT_SBAR() __builtin_amdgcn_sched_barrier(0)
#define ATT_MFMA(a, b, c) __builtin_amdgcn_mfma_f32_32x32x16_bf16(a, b, c, 0, 0, 0)
#define ATT_VTR(p) __builtin_amdgcn_ds_read_tr16_b64_v4i16((LAS v4i16_t*)(p))

__device__ __forceinline__ void attn_unit(LAS unsigned char* lds, const bf16_t* PROJ, bf16_t* OCAT, const float* subg, float lam, float oml, int b, int h, int qb) {
    const int tid = opaque_tid(), lane = tid & 63, r32 = lane & 31, hi = lane >> 5, wid = __builtin_amdgcn_readfirstlane(tid >> 6), comp = wid >> 2, wq = wid & 3;
    const size_t rowbase = (size_t)b * SEQ; const int q0 = qb * 128;
    bf16x8 qr[4];
    { const bf16_t* qp = PROJ + (rowbase + q0 + wq * 32 + r32) * PP + h * 128 + comp * 64 + hi * 8;
#pragma unroll
      for (int d0 = 0; d0 < 4; ++d0) qr[d0] = *(const bf16x8*)(qp + d0 * 16); }
    constexpr int KSL = 18432, VB = 2 * KSL, VSL = 20480;
    const int krow = tid >> 3, kch = tid & 7, vrow0 = tid >> 4, vch = tid & 15;
    const bf16_t* kg = PROJ + (rowbase + krow) * PP + C_K + h * 128 + kch * 8;
    const bf16_t* vg = PROJ + (rowbase + vrow0) * PP + C_V + h * 128 + vch * 8;
    const int kst = krow * 144 + kch * 16, vst = VB + vrow0 * 320 + vch * 16;
    const int rot = qb * 2;
    u32x4 ga0, ga1, ga2, ga3;
#define ATT_LOAD(S, t) do { const size_t o_ = (size_t)(((t) + rot) & 31) * 64 * PP; g##S##0 = *(const u32x4*)(kg + o_); g##S##1 = *(const u32x4*)(kg + o_ + 64); g##S##2 = *(const u32x4*)(vg + o_); g##S##3 = *(const u32x4*)(vg + o_ + (size_t)32 * PP); } while (0)
#define ATT_STORE(S, ks, vs) do { *(LAS u32x4*)(lds + (ks) + kst) = g##S##0; *(LAS u32x4*)(lds + (ks) + 9216 + kst) = g##S##1; *(LAS u32x4*)(lds + (vs) + vst) = g##S##2; *(LAS u32x4*)(lds + (vs) + vst + 32 * 320) = g##S##3; } while (0)
    const int kread = comp * 9216 + r32 * 144 + hi * 16;
    const int vread = VB + (4 * hi + ((lane & 15) >> 2)) * 320 + ((lane >> 4) & 1) * 32 + (lane & 3) * 8;
    f32x16 o[4];
#pragma unroll
    for (int i = 0; i < 4; ++i)
#pragma unroll
        for (int r = 0; r < 16; ++r) o[i][r] = 0.f;
    float mrun, lrun = 0.f;
    f32x16 pA0, pA1, pB0, pB1, negm;
    const f32x16 zero16 = {0.f, 0.f, 0.f, 0.f, 0.f, 0.f, 0.f, 0.f, 0.f, 0.f, 0.f, 0.f, 0.f, 0.f, 0.f, 0.f};

    bf16x8 kf0, kf1, kf2, kf3, kf4, kf5, kf6, kf7;
#define ATT_KRD(ks) do { const LAS unsigned char* kb_ = lds + (ks) + kread; \
        kf0 = *(const LAS bf16x8*)(kb_); kf1 = *(const LAS bf16x8*)(kb_ + 32 * 144); kf2 = *(const LAS bf16x8*)(kb_ + 32); kf3 = *(const LAS bf16x8*)(kb_ + 32 * 144 + 32); \
        kf4 = *(const LAS bf16x8*)(kb_ + 64); kf5 = *(const LAS bf16x8*)(kb_ + 32 * 144 + 64); kf6 = *(const LAS bf16x8*)(kb_ + 96); kf7 = *(const LAS bf16x8*)(kb_ + 32 * 144 + 96); } while (0)
    ATT_LOAD(a, 0); ATT_STORE(a, 0, 0); ATT_LOAD(a, 1); __syncthreads();
    {
        ATT_KRD(0);
        pA0 = ATT_MFMA(kf0, qr[0], zero16); pA1 = ATT_MFMA(kf1, qr[0], zero16);
        pA0 = ATT_MFMA(kf2, qr[1], pA0); pA1 = ATT_MFMA(kf3, qr[1], pA1);
        pA0 = ATT_MFMA(kf4, qr[2], pA0); pA1 = ATT_MFMA(kf5, qr[2], pA1);
        pA0 = ATT_MFMA(kf6, qr[3], pA0); pA1 = ATT_MFMA(kf7, qr[3], pA1);
        float mx = fmaxf(pA0[0], pA1[0]);
#pragma unroll
        for (int r = 1; r < 16; ++r) mx = fmaxf(mx, fmaxf(pA0[r], pA1[r]));
        mrun = half_max(mx);
#pragma unroll
        for (int r = 0; r < 16; ++r) { pA0[r] = __builtin_amdgcn_exp2f(pA0[r] - mrun); pA1[r] = __builtin_amdgcn_exp2f(pA1[r] - mrun); negm[r] = -mrun; }
        asm volatile("" : "+v"(negm));
    }
    ATT_STORE(a, KSL, VSL); ATT_LOAD(a, 2); __syncthreads();
    ATT_KRD(KSL);
    int vs_prev = 0, vs_store = 2 * VSL;

#define ATT_PIN(x) asm volatile("" : "+v"(x))
#define ATT_GA(MF, A0, A1, A2, A3, W0, W1, PW) do { MF; sacc += A0; sacc2 += A1; sacc += A2; sacc2 += A3; ATT_PIN(sacc); ATT_PIN(sacc2); W0; W1; ATT_PIN(PW); ATT_SBAR(); } while (0)
#define ATT_VRD(dst, ms, dvb) do { const v4i16_t lo_ = ATT_VTR(vb_ + (ms) * 16 * 320 + (dvb) * 64), hh_ = ATT_VTR(vb_ + ((ms) * 16 + 8) * 320 + (dvb) * 64); \
        dst = (bf16x8){lo_[0], lo_[1], lo_[2], lo_[3], hh_[0], hh_[1], hh_[2], hh_[3]}; } while (0)
#define ATT_GB(ms, dvb, X, j, HASN, nms) do { \
        o[dvb] = ATT_MFMA(vf##dvb, __builtin_bit_cast(bf16x8, pw##ms), o[dvb]); \
        if (HASN) ATT_VRD(vf##dvb, nms, dvb); \
        X[j] = __builtin_amdgcn_exp2f(X[j]); X[(j) + 1] = __builtin_amdgcn_exp2f(X[(j) + 1]); ATT_PIN(X); \
        if (PROBE_EXP) { float d0_, d1_; asm volatile("v_exp_f32 %0, %2\n\tv_exp_f32 %1, %3" : "=&v"(d0_), "=&v"(d1_) : "v"(X[j]), "v"(X[(j) + 1])); } \
        ATT_SBAR(); } while (0)
#define ATT_STEP(C0, C1, P0, P1, t, MORE) do { \
        if (MORE) ATT_STORE(a, (((t) + 1) & 1) * KSL, vs_store);     \
        const LAS unsigned char* vb_ = lds + vs_prev + vread; \
        u32x4 pw0, pw1, pw2, pw3; float sacc = P0[0], sacc2 = P0[1]; bf16x8 vf0, vf1, vf2, vf3; \
        ATT_SBAR(); \
        ATT_GA(C0 = ATT_MFMA(kf0, qr[0], negm), P0[2], P0[3], P0[4], P0[5],     pw0.x = cvtpk_s(P0[0], P0[1]),   pw0.y = cvtpk_s(P0[2], P0[3]), pw0); \
        ATT_GA(C1 = ATT_MFMA(kf1, qr[0], negm), P0[6], P0[7], P0[8], P0[9],     pw0.z = cvtpk_s(P0[4], P0[5]),   pw0.w = cvtpk_s(P0[6], P0[7]), pw0); \
        ATT_GA(C0 = ATT_MFMA(kf2, qr[1], C0),     P0[10], P0[11], P0[12], P0[13], pw1.x = cvtpk_s(P0[8], P0[9]),   pw1.y = cvtpk_s(P0[10], P0[11]), pw1); \
        ATT_GA(C1 = ATT_MFMA(kf3, qr[1], C1),     P0[14], P0[15], P1[0], P1[1],   pw1.z = cvtpk_s(P0[12], P0[13]), pw1.w = cvtpk_s(P0[14], P0[15]), pw1); \
        ATT_VRD(vf0, 0, 0); ATT_GA(C0 = ATT_MFMA(kf4, qr[2], C0),     P1[2], P1[3], P1[4], P1[5],     pw2.x = cvtpk_s(P1[0], P1[1]),   pw2.y = cvtpk_s(P1[2], P1[3]), pw2); \
        ATT_VRD(vf1, 0, 1); ATT_GA(C1 = ATT_MFMA(kf5, qr[2], C1),     P1[6], P1[7], P1[8], P1[9],     pw2.z = cvtpk_s(P1[4], P1[5]),   pw2.w = cvtpk_s(P1[6], P1[7]), pw2); \
        ATT_VRD(vf2, 0, 2); ATT_GA(C0 = ATT_MFMA(kf6, qr[3], C0),     P1[10], P1[11], P1[12], P1[13], pw3.x = cvtpk_s(P1[8], P1[9]),   pw3.y = cvtpk_s(P1[10], P1[11]), pw3); \
        ATT_VRD(vf3, 0, 3); ATT_GA(C1 = ATT_MFMA(kf7, qr[3], C1),     P1[14], P1[15], 0.f, 0.f,       pw3.z = cvtpk_s(P1[12], P1[13]), pw3.w = cvtpk_s(P1[14], P1[15]), pw3); \
        lrun += sacc + sacc2; \
        asm volatile("s_nop 15\n\ts_nop 7" : "+v"(C0), "+v"(C1));     \
        float mxa_ = max3f(C0[0], C0[1], C1[0]), mxb_ = max3f(C0[2], C0[3], C1[1]); mxa_ = max3f(mxa_, C1[2], C1[3]); \
        _Pragma("unroll") for (int r = 4; r < 16; r += 4) { mxa_ = max3f(mxa_, C0[r], C0[r + 1]); mxb_ = max3f(mxb_, C0[r + 2], C0[r + 3]); mxa_ = max3f(mxa_, C1[r], C1[r + 1]); mxb_ = max3f(mxb_, C1[r + 2], C1[r + 3]); } \
        float mx_ = half_max(max2f(mxa_, mxb_)); \
        float f_ = 1.0f; \
        if (__builtin_expect(__any(mx_ > 8.0f), 0)) {     \
            const float dl_ = fmaxf(mx_, 0.f); mrun += dl_; f_ = __builtin_amdgcn_exp2f(-dl_); lrun *= f_; \
            _Pragma("unroll") for (int r = 0; r < 16; ++r) { C0[r] -= dl_; C1[r] -= dl_; negm[r] = -mrun; } \
            asm volatile("" : "+v"(negm)); } \
        ATT_SBAR(); \
        if (MORE) { asm volatile("s_waitcnt lgkmcnt(0)" ::: "memory"); __builtin_amdgcn_s_barrier(); asm volatile("" ::: "memory"); \
            ATT_LOAD(a, (t) + 2); ATT_KRD((((t) + 1) & 1) * KSL); } \
        ATT_SBAR(); \
        ATT_GB(0, 0, C0, 0, true, 1);  ATT_GB(0, 1, C0, 2, true, 1);  ATT_GB(0, 2, C0, 4, true, 1);  ATT_GB(0, 3, C0, 6, true, 1); \
        ATT_GB(1, 0, C0, 8, true, 2);  ATT_GB(1, 1, C0, 10, true, 2); ATT_GB(1, 2, C0, 12, true, 2); ATT_GB(1, 3, C0, 14, true, 2); \
        ATT_GB(2, 0, C1, 0, true, 3);  ATT_GB(2, 1, C1, 2, true, 3);  ATT_GB(2, 2, C1, 4, true, 3);  ATT_GB(2, 3, C1, 6, true, 3); \
        ATT_GB(3, 0, C1, 8, false, 0); ATT_GB(3, 1, C1, 10, false, 0); ATT_GB(3, 2, C1, 12, false, 0); ATT_GB(3, 3, C1, 14, false, 0); \
        if (__any(f_ != 1.0f)) { \
            _Pragma("unroll") for (int i = 0; i < 4; ++i) _Pragma("unroll") for (int r = 0; r < 16; ++r) o[i][r] *= f_; } \
        vs_prev = (vs_prev == 3 * VSL) ? 0 : vs_prev + VSL; vs_store = (vs_store == 3 * VSL) ? 0 : vs_store + VSL; \
    } while (0)

    for (int t = 1; t < 31; t += 2) {
        ATT_STEP(pB0, pB1, pA0, pA1, t, true);
        ATT_STEP(pA0, pA1, pB0, pB1, t + 1, true);
    }
    ATT_STEP(pB0, pB1, pA0, pA1, 31, false);
    {
        float sacc = 0.f;
#pragma unroll
        for (int r = 0; r < 16; ++r) sacc += pB0[r] + pB1[r];
        lrun += sacc;
        u32x4 pw0, pw1, pw2, pw3;
        pw0.x = cvtpk_s(pB0[0], pB0[1]); pw0.y = cvtpk_s(pB0[2], pB0[3]); pw0.z = cvtpk_s(pB0[4], pB0[5]); pw0.w = cvtpk_s(pB0[6], pB0[7]);
        pw1.x = cvtpk_s(pB0[8], pB0[9]); pw1.y = cvtpk_s(pB0[10], pB0[11]); pw1.z = cvtpk_s(pB0[12], pB0[13]); pw1.w = cvtpk_s(pB0[14], pB0[15]);
        pw2.x = cvtpk_s(pB1[0], pB1[1]); pw2.y = cvtpk_s(pB1[2], pB1[3]); pw2.z = cvtpk_s(pB1[4], pB1[5]); pw2.w = cvtpk_s(pB1[6], pB1[7]);
        pw3.x = cvtpk_s(pB1[8], pB1[9]); pw3.y = cvtpk_s(pB1[10], pB1[11]); pw3.z = cvtpk_s(pB1[12], pB1[13]); pw3.w = cvtpk_s(pB1[14], pB1[15]);
        const LAS unsigned char* vb_ = lds + vs_prev + vread;
#define ATT_GD(ms, dvb) do { \
        const v4i16_t lo_ = ATT_VTR(vb_ + (ms) * 16 * 320 + (dvb) * 64), hh_ = ATT_VTR(vb_ + ((ms) * 16 + 8) * 320 + (dvb) * 64); \
        const bf16x8 vf_ = (bf16x8){lo_[0], lo_[1], lo_[2], lo_[3], hh_[0], hh_[1], hh_[2], hh_[3]}; \
        o[dvb] = ATT_MFMA(vf_, __builtin_bit_cast(bf16x8, pw##ms), o[dvb]); } while (0)
        ATT_GD(0, 0); ATT_GD(0, 1); ATT_GD(0, 2); ATT_GD(0, 3); ATT_GD(1, 0); ATT_GD(1, 1); ATT_GD(1, 2); ATT_GD(1, 3);
        ATT_GD(2, 0); ATT_GD(2, 1); ATT_GD(2, 2); ATT_GD(2, 3); ATT_GD(3, 0); ATT_GD(3, 1); ATT_GD(3, 2); ATT_GD(3, 3);
#undef ATT_GD
    }
    __syncthreads();
#undef ATT_LOAD
#undef ATT_STORE
#undef ATT_GA
#undef ATT_GB
#undef ATT_STEP
#undef ATT_KRD
#undef ATT_VRD
#undef ATT_PIN
    for (int rep_ = 0; rep_ <= PROBE_EPI; ++rep_) {
    {
        const float ltot = half_sum(lrun);
        float inv = 1.0f / ltot; if (comp == 1) inv *= lam;
        LAS float* cb = (LAS float*)lds + comp * (128 * 132) + (wq * 32 + r32) * 132 + 4 * hi;
#pragma unroll
        for (int dvb = 0; dvb < 4; ++dvb)
#pragma unroll
            for (int k4 = 0; k4 < 4; ++k4) {
                const f32x4 v = (f32x4){o[dvb][4 * k4 + 0] * inv, o[dvb][4 * k4 + 1] * inv, o[dvb][4 * k4 + 2] * inv, o[dvb][4 * k4 + 3] * inv};
                *(LAS f32x4*)(cb + dvb * 32 + 8 * k4) = v;
            }
    }
    __syncthreads();
    {
        const int q2 = tid >> 2, part = tid & 3;
        const LAS float* a0 = (const LAS float*)lds + q2 * 132 + part * 32; const LAS float* a1 = a0 + 128 * 132;
        f32x4 a[8]; float ss = 0.f;
#pragma unroll
        for (int i = 0; i < 8; ++i) { a[i] = *(const LAS f32x4*)(a0 + 4 * i) - *(const LAS f32x4*)(a1 + 4 * i); ss += (a[i].x * a[i].x + a[i].y * a[i].y) + (a[i].z * a[i].z + a[i].w * a[i].w); }
        ss += __shfl_xor(ss, 1); ss += __shfl_xor(ss, 2);
        const float rs = rsqrtf(ss * (1.0f / 128.0f) + EPS) * oml;
        const size_t row = rowbase + q0 + q2;
        const bf16_t* zp = PROJ + row * PP + C_ZA + h * 128 + part * 32; bf16_t* op = OCAT + row * 2048 + h * 128 + part * 32; const float* gp = subg + part * 32;
#pragma unroll
        for (int i = 0; i < 4; ++i) {
            const u32x4 z = *(const u32x4*)(zp + 8 * i); const f32x4 ga = *(const f32x4*)(gp + 8 * i), gb = *(const f32x4*)(gp + 8 * i + 4);
            const f32x4 xa = a[2 * i] * rs * ga, xb = a[2 * i + 1] * rs * gb;
            u32x4 w; w.x = cvt_pk_bf16(xa.x * silu_f(bflo(z.x)), xa.y * silu_f(bfhi(z.x))); w.y = cvt_pk_bf16(xa.z * silu_f(bflo(z.y)), xa.w * silu_f(bfhi(z.y)));
            w.z = cvt_pk_bf16(xb.x * silu_f(bflo(z.z)), xb.y * silu_f(bfhi(z.z))); w.w = cvt_pk_bf16(xb.z * silu_f(bflo(z.w)), xb.w * silu_f(bfhi(z.w)));
            *(u32x4*)(op + 8 * i) = w;
        }
    }
    __syncthreads();
    }
}

struct Args { const float* in[24]; float* out; unsigned char* ws; };
typedef const Args __attribute__((address_space(4)))* KArgsPtr;
__device__ __forceinline__ KArgsPtr kargs() { KArgsPtr p = (KArgsPtr)__builtin_amdgcn_kernarg_segment_ptr(); asm volatile("" : "+s"(p)); return p; }
#define WSP(T, off) ((T*)(ap->ws + (off)))

__global__ void __launch_bounds__(512, 2) fwd_megakernel(Args a_unused) {
    extern __shared__ __attribute__((aligned(16))) unsigned char lds_raw[];
    LAS unsigned char* lds = (LAS unsigned char*)lds_raw;
    cg::grid_group grid = cg::this_grid();
    const int G = gridDim.x, bx = blockIdx.x;
    const int NGW = G * 8;
#define PH_TID() const int tid = opaque_tid(), lane = tid & 63, wave = __builtin_amdgcn_readfirstlane(tid >> 6), gw = bx * 8 + wave; (void)lane; (void)gw; KArgsPtr ap = kargs()

#define XSYNC1() do { KArgsPtr ap_ = kargs(); XcdBarrier b_; b_.bar = (unsigned*)(ap_->ws + WS_BAR); b_.x = xb_xcc_id(); b_.st = (volatile LAS unsigned*)(lds + 139200); xcd_barrier(b_); } while (0)
#define GSYNC() do { XSYNC1(); if (PROBE_SYNC) XSYNC1(); } while (0)
    { if (threadIdx.x < 2) ((volatile LAS unsigned*)(lds + 139200))[threadIdx.x] = 0u; __syncthreads(); KArgsPtr ap_ = kargs(); xcd_barrier_post((unsigned*)(ap_->ws + WS_BAR)); }
    for (int r_ = 0; r_ <= (PROBE_P0 & 1); ++r_)
    { PH_TID();
      if (bx < 192) {
        LAS float* cond = (LAS float*)lds; const float* c_in = ap->in[1];
#pragma unroll 8
        for (int i = tid; i < 2048 * 8; i += 512) { const int b = i >> 11, k = i & 2047; cond[k * 8 + b] = silu_f(c_in[i]); }
        __syncthreads();
        for (int it = bx; it < 192; it += G) mod_item(it, ap->in[4], ap->in[5], WSP(float, WS_MOD), lds, tid);
      }
    }
    for (int r_ = 0; r_ <= ((PROBE_P0 >> 1) & 1); ++r_)
    { PH_TID();
      SsmIn sin_; sin_.a_re = ap->in[13]; sin_.a_im = ap->in[14]; sin_.log_dt = ap->in[15]; sin_.b_re = ap->in[16]; sin_.b_im = ap->in[17]; sin_.c_re = ap->in[18]; sin_.c_im = ap->in[19]; sin_.d_skip = ap->in[20];
      for (int it = (G - 1 - bx); it < 4 * NGRP; it += G) { const int l = it >> 7, g = (it >> 1) & 63;
          ssm_gen_item(l, g, it & 1, sin_, WSP(bf16_t, WS_WCAT) + l * WCAT_L, WSP(bf16_t, WS_WST) + l * WST_L, WSP(float, WS_LAMT) + l * LAMT_L, lds, tid); }
    }
    for (int r_ = 0; r_ <= ((PROBE_P0 >> 2) & 1); ++r_)
    { PH_TID();
        const float* w_in = ap->in[6]; const float* w_out = ap->in[7]; const float* w_glu = ap->in[21];
        bf16_t* WIN = WSP(bf16_t, WS_WIN); bf16_t* WOUT = WSP(bf16_t, WS_WOUT); bf16_t* WGLU = WSP(bf16_t, WS_WGLU);
        LAS float* scr = (LAS float*)(lds + wave * 16384);
        constexpr int I_IN = 32 * 192, I_OUT = 32 * 64, I_GLU = 16 * 64, NIT = 2 * (I_IN + I_OUT + I_GLU);
        for (int it = gw; it < NIT; it += NGW) {
            int r = it;
            if (r < 2 * I_IN) { const int l = r / I_IN, q = r % I_IN, kb = q / 192, nb = q % 192;
                transpose_item(w_in + (size_t)l * 2048 * 6144, 2048, 6144, WIN + (size_t)l * 6144 * 2048, kb * 64, nb * 32, nb * 32, scr, lane); continue; }
            r -= 2 * I_IN;
            if (r < 2 * I_OUT) { const int l = r / I_OUT, q = r % I_OUT, kb = q / 64, nb = q % 64;
                transpose_item(w_out + (size_t)l * 2048 * 2048, 2048, 2048, WOUT + (size_t)l * 2048 * 2048, kb * 64, nb * 32, nb * 32, scr, lane); continue; }
            r -= 2 * I_OUT;
            { const int l = r / I_GLU, q = r % I_GLU, kb = q / 64, nb = q % 64, n0 = nb * 32, bj = n0 >> 10, rem = n0 & 1023, pn = rem >> 7, jj = rem & 127;
              transpose_item(w_glu + (size_t)l * 1024 * 2048, 1024, 2048, WGLU + (size_t)l * 2048 * 1024, kb * 64, n0, pn * 256 + bj * 128 + jj, scr, lane); }
        }
    }
    for (int r_ = 0; r_ <= ((PROBE_P0 >> 3) & 1); ++r_)
    { PH_TID();
      const int* pos = (const int*)ap->in[2]; float* ROT = WSP(float, WS_ROT);
      for (int i = bx * 512 + tid; i < MTOK * 8; i += G * 512) {
        const int tok = i >> 3, j = i & 7;
        const float inv = exp2f(-(float)j * 0.125f * 18.931568569324174f);
        const float ang = (float)pos[tok] * inv; float s, c; sincosf(ang, &s, &c);
        ROT[(size_t)tok * 16 + j] = c; ROT[(size_t)tok * 16 + 8 + j] = s;
      }
      if (bx == 0 && wave < 2) {
        const float v1 = wave_sum(ap->in[8][wave * 64 + lane] * ap->in[9][wave * 64 + lane]), v2 = wave_sum(ap->in[10][wave * 64 + lane] * ap->in[11][wave * 64 + lane]);
        const float lam_init = 0.8f - 0.6f * expf(-0.3f * (float)wave);
        if (lane == 0) WSP(float, WS_LAMV)[wave] = expf(v1) - expf(v2) + lam_init;
      }
    }
    if (gridDim.y == 0x7fffu) grid.sync();
    GSYNC();
    { PH_TID(); norm_rows(ap->in[0], ap->in[3], WSP(float, WS_MOD), WSP(bf16_t, WS_H), nullptr, 0, gw, NGW, lane, (bf16_t*)ap->out); }
    GSYNC();

#pragma unroll 1
    for (int layer = 0; layer < 2; ++layer) {
        { KArgsPtr ap = kargs();
          pg8::StaticOrder S; S.init(MTOK, DIN, G, bx, WSP(bf16_t, WS_H), WSP(bf16_t, WS_WIN) + (size_t)layer * 6144 * 2048, DM, DM);
          EpiInProj E{ap->ws};
          for (int rep = 0; rep <= PROBE_INPROJ; ++rep) pg8::gemm_phase<INPROJ_SP2>(lds, DM, DM, DM, S, E); }
        GSYNC();
        { KArgsPtr ap = kargs();
          const int vcu = (G % 8 == 0) ? (bx % 8) * (G / 8) + bx / 8 : bx;
          pg8::GroupOrder S; S.init(NGRP, 2, 1, G, vcu, WSP(bf16_t, WS_ACOMB), WSP(bf16_t, WS_WST) + layer * WST_L, KA, 512, (size_t)RG * KA * 2, (size_t)256 * 512 * 2);
          EpiS1 E{WSP(float, WS_SBUF)};
          pg8::gemm_phase(lds, 512, KA, 512, S, E);
          if (PROBE_SSM & 1) pg8::gemm_phase(lds, 512, KA, 512, S, E); }
        GSYNC();
        for (int rep = 0; rep <= ((PROBE_SSM >> 1) & 1); ++rep) { PH_TID(); s2_phase(WSP(float, WS_SBUF), WSP(bf16_t, WS_ACOMB), WSP(float, WS_LAMT) + layer * LAMT_L, bx, tid); }
        { KArgsPtr ap = kargs();
          const int vcu = (G % 8 == 0) ? (bx % 8) * (G / 8) + bx / 8 : bx;
          const float lam = WSP(float, WS_LAMV)[layer], lam_init = 0.8f - 0.6f * expf(-0.3f * (float)layer);
          const bf16_t* PROJ = WSP(bf16_t, WS_PROJ); bf16_t* OCAT = WSP(bf16_t, WS_H); const float* subg = ap->in[12] + layer * 128;
          for (int rep = 0; rep <= PROBE_ATT; ++rep)
          for (int un = vcu; un < NB * NHEAD * 16; un += G) { const int bh = un >> 4, qb = un & 15; attn_unit(lds, PROJ, OCAT, subg, lam, 1.0f - lam_init, bh >> 3, bh & 7, qb); } }
        GSYNC();
        { KArgsPtr ap = kargs();
          const int vcu = (G % 8 == 0) ? (bx % 8) * (G / 8) + bx / 8 : bx;
          pg8::GroupOrder S; S.init(NGRP, 2, 2, G, vcu, WSP(bf16_t, WS_ACOMB), WSP(bf16_t, WS_WCAT) + layer * WCAT_L, KA, KA, (size_t)RG * KA * 2, (size_t)512 * KA * 2);
          EpiS3 E{WSP(bf16_t, WS_YG)};
          pg8::gemm_phase(lds, KA, KA, KA, S, E);
          if (PROBE_SSM & 4) pg8::gemm_phase(lds, KA, KA, KA, S, E); }
        GSYNC();
        { KArgsPtr ap = kargs();
          pg8::StaticOrder S; S.init(MTOK, 2048, G, bx, WSP(bf16_t, WS_YG), WSP(bf16_t, WS_WGLU) + (size_t)layer * 2048 * 1024, 1024, 1024);
          EpiGLU E{ap->ws, ap->in[22] + layer * 2048};
          for (int rep = 0; rep <= PROBE_GLU; ++rep) pg8::gemm_phase(lds, 1024, 1024, 1024, S, E); }
        GSYNC();
        { KArgsPtr ap = kargs();
          pg8::PanelOrder S; S.init(bx, WSP(bf16_t, WS_H), WSP(bf16_t, WS_WOUT) + (size_t)layer * 2048 * 2048, DM, DM);
          EpiOutNorm E{ap->out, WSP(float, WS_MOD) + (size_t)layer * 8 * 6144 + 4096, WSP(float, WS_RSS) + layer * 16384, WSP(unsigned, WS_CNT) + layer * 64 * 64,
                       layer == 0 ? ap->in[3] + DM : ap->in[23], WSP(float, WS_MOD) + (size_t)8 * 6144, WSP(bf16_t, WS_H), layer, ap->ws};
          pg8::gemm_phase(lds, DM, DM, DM, S, E); }
        if (layer == 0) GSYNC();
    }
}

extern "C" void kernel_launch(void* const* d_in, const int* in_sizes, int n_in, void* d_out, int out_size, void* d_ws, size_t ws_size, hipStream_t stream) {
    static int grid = 0;
    if (grid == 0) {
        if (n_in != 24 || out_size != MTOK * DM || ws_size < WS_END) { fprintf(stderr, "kernel_launch: unexpected shapes (n_in %d out %d ws %zu)\n", n_in, out_size, ws_size); grid = -1; return; }
        int dev = 0, cus = 0, per_cu = 0;
        (void)hipGetDevice(&dev);
        (void)hipDeviceGetAttribute(&cus, hipDeviceAttributeMultiprocessorCount, dev);
        (void)hipFuncSetAttribute((const void*)fwd_megakernel, hipFuncAttributeMaxDynamicSharedMemorySize, LDS_BYTES);
        (void)hipOccupancyMaxActiveBlocksPerMultiprocessor(&per_cu, (const void*)fwd_megakernel, 512, LDS_BYTES);
        if (per_cu < 1) { fprintf(stderr, "kernel_launch: occupancy query says %d blocks per CU\n", per_cu); per_cu = 1; }
        if (cus != 256) { fprintf(stderr, "kernel_launch: built for 256 CUs (got %d)\n", cus); grid = -1; return; }
        grid = cus;
    }
    if (grid < 0) return;
    (void)hipMemsetAsync((char*)d_ws + WS_BAR, 0, CTL_BYTES, stream);
    Args a{};
    for (int i = 0; i < 24; ++i) a.in[i] = (const float*)d_in[i];
    a.out = (float*)d_out; a.ws = (unsigned char*)d_ws;
    void* args[] = {&a};
    hipError_t e = hipLaunchCooperativeKernel((void*)fwd_megakernel, dim3(grid), dim3(512), args, LDS_BYTES, stream);
    if (e != hipSuccess) fprintf(stderr, "cooperative launch failed: %s (grid %d)\n", hipGetErrorString(e), grid);
}
```

```cpp
#include <hip/hip_runtime.h>
#include <hip/hip_cooperative_groups.h>
#include <cstdio>
#include <cstdint>
#include <cmath>
namespace cg = cooperative_groups;
#ifndef PROBE_SYNC
#define PROBE_SYNC 0
#endif
#ifndef PROBE_ATT
#define PROBE_ATT 0
#endif
#ifndef PROBE_INPROJ
#define PROBE_INPROJ 0
#endif
#ifndef PROBE_EPI
#define PROBE_EPI 0
#endif
#ifndef PROBE_EXP
#define PROBE_EXP 0
#endif
#ifndef INPROJ_SP2
#define INPROJ_SP2 true
#endif
#ifndef PROBE_SSM
#define PROBE_SSM 0
#endif
#ifndef PROBE_GLU
#define PROBE_GLU 0
#endif
#ifndef PROBE_P0
#define PROBE_P0 0
#endif

#define LAS __attribute__((address_space(3)))
typedef unsigned short bf16_t;
typedef short bf16x8 __attribute__((ext_vector_type(8)));
typedef short v4i16_t __attribute__((ext_vector_type(4)));
typedef float f32x4 __attribute__((ext_vector_type(4)));
typedef float f32x16 __attribute__((ext_vector_type(16)));
typedef unsigned u32x4 __attribute__((ext_vector_type(4)));
typedef unsigned u32x2 __attribute__((ext_vector_type(2)));

constexpr int NB = 8, SEQ = 2048, DM = 2048, MTOK = NB * SEQ, DIN = 6144, NHEAD = 8, NGRP = 64;
constexpr int TCH = 32, KA = TCH * 16 + 256  , RG = MTOK / TCH  ;
constexpr int PP = 5120;
constexpr int C_K = 1024, C_V = 2048, C_ZA = 3072, C_ZS = 4096;
constexpr float EPS = 1e-6f;
constexpr float QSCALE = 0.125f * 1.4426950408889634f;
constexpr int LDS_BYTES = 139264;
constexpr size_t MiB = 1u << 20;
constexpr size_t WS_MOD = 0, WS_LAMT = 512 * 1024, WS_LAMV = 768 * 1024, WS_BAR = 800 * 1024, BAR_BYTES = 16384, WS_RSS = WS_BAR + BAR_BYTES  , WS_CNT = WS_RSS + 2 * 16384 * 4  , CTL_BYTES = BAR_BYTES + 2 * 16384 * 4 + 2 * 64 * 64 * 4, WS_ROT = 1 * MiB, WS_WIN = 2 * MiB, WS_WOUT = 50 * MiB, WS_WGLU = 66 * MiB,
                 WS_WCAT = 74 * MiB, WS_WST = 170 * MiB, WS_H = 202 * MiB, WS_PROJ = 266 * MiB, WS_ACOMB = 426 * MiB, WS_SBUF = 474 * MiB, WS_YG = 474 * MiB  , WS_END = 506 * MiB;
constexpr size_t WCAT_L = (size_t)NGRP * 512 * KA, WST_L = (size_t)NGRP * 256 * 512, LAMT_L = (size_t)NGRP * 2 * 64 * 2;

__device__ __forceinline__ unsigned cvt_pk_bf16(float lo, float hi) { unsigned r; asm volatile("v_cvt_pk_bf16_f32 %0, %1, %2" : "=v"(r) : "v"(lo), "v"(hi)); return r; }
__device__ __forceinline__ unsigned f2bf(float f) { unsigned u = __builtin_bit_cast(unsigned, f); return (u + 0x7fffu + ((u >> 16) & 1u)) >> 16; }
__device__ __forceinline__ unsigned pk2(float lo, float hi) { return f2bf(lo) | (f2bf(hi) << 16); }
__device__ __forceinline__ float bflo(unsigned w) { return __uint_as_float(w << 16); }
__device__ __forceinline__ float bfhi(unsigned w) { return __uint_as_float(w & 0xffff0000u); }
__device__ __forceinline__ float wave_sum(float v) {
#pragma unroll
    for (int o = 1; o < 64; o <<= 1) v += __shfl_xor(v, o);
    return v;
}
__device__ __forceinline__ int opaque_tid() { int t = threadIdx.x; asm volatile("" : "+v"(t)); return t; }
__device__ __forceinline__ float silu_f(float z) { return z / (1.0f + __expf(-z)); }
__device__ __forceinline__ float sigmoid_f(float z) { return 1.0f / (1.0f + __expf(-z)); }
__device__ __forceinline__ float gelu_tanh_f(float y) { const float t = 0.7978845608028654f * (y + 0.044715f * y * y * y); return y * sigmoid_f(2.0f * t); }


#define XB_TMO      128
#define XB_XCNT(j)  (256  + 64 * (j))
#define XB_XSUB(j)  (1280 + 64 * (j))
#define XB_XGEN(j)  (2304 + 64 * (j))
#define XB_TOP      3328
#define XB_TOPGEN   3392
#define XCD_BAR_WORDS 3456
#define XB_SPIN_CAP (1u << 18)
__device__ __forceinline__ unsigned xb_ld(unsigned* p)              { return __hip_atomic_load(p, __ATOMIC_RELAXED, __HIP_MEMORY_SCOPE_AGENT); }
__device__ __forceinline__ unsigned xb_add(unsigned* p, unsigned v) { return __hip_atomic_fetch_add(p, v, __ATOMIC_RELAXED, __HIP_MEMORY_SCOPE_AGENT); }
__device__ __forceinline__ unsigned xb_xcc_id() { return (unsigned)__builtin_amdgcn_s_getreg((3 << 11) | 20) & 0xFu; }
#define XB_SPIN(cond, bar) do { unsigned _sp = 0; while (cond) { __builtin_amdgcn_s_sleep(1); \
    if ((++_sp & 255u) == 0u) { if (xb_ld(&(bar)[XB_TMO])) break; if (_sp > XB_SPIN_CAP) { atomicAdd(&(bar)[XB_TMO], 1u); break; } } } } while (0)
struct XcdBarrier { unsigned* bar; unsigned x; volatile LAS unsigned* st; };
__device__ __forceinline__ void xcd_barrier_post(unsigned* bar) { if (threadIdx.x == 0) (void)xb_add(&bar[XB_XCNT(xb_xcc_id())], 1u); }
__device__ __forceinline__ void xcd_barrier_complete(unsigned* bar, unsigned x, unsigned& nloc, unsigned& nx) {
    const unsigned G = gridDim.x * gridDim.y * gridDim.z;
    unsigned sum, cnt, mine, sp = 0u;
    for (;;) {
        sum = 0u; cnt = 0u; mine = 0u;
#pragma unroll
        for (unsigned j = 0; j < 16; ++j) { const unsigned c = xb_ld(&bar[XB_XCNT(j)]); sum += c; cnt += (c > 0u) ? 1u : 0u; mine = (j == x) ? c : mine; }
        if (sum == G) break;
        __builtin_amdgcn_s_sleep(1);
        if ((++sp & 255u) == 0u) { if (xb_ld(&bar[XB_TMO])) break; if (sp > XB_SPIN_CAP) { atomicAdd(&bar[XB_TMO], 1u); break; } }
    }
    nloc = mine > 0u ? mine : 1u; nx = cnt > 0u ? cnt : 1u;
}
__device__ __forceinline__ void xcd_barrier(const XcdBarrier& b) {
    asm volatile("s_waitcnt vmcnt(0)" ::: "memory");
    __syncthreads();
    if (threadIdx.x == 0) {
        unsigned* bar = b.bar;
        __builtin_amdgcn_s_waitcnt(0);
        unsigned nloc = b.st[0], nx = b.st[1];
        if (nloc == 0u) { xcd_barrier_complete(bar, b.x, nloc, nx); b.st[0] = nloc; b.st[1] = nx; }
        const unsigned old = xb_add(&bar[XB_XSUB(b.x)], 1u);
        const unsigned gen = old / nloc;
        if (old + 1u == (gen + 1u) * nloc) {
            __builtin_amdgcn_fence(__ATOMIC_RELEASE, "agent");
            asm volatile("s_waitcnt vmcnt(0)" ::: "memory");
            const unsigned og = xb_add(&bar[XB_TOP], 1u);
            const unsigned tg = og / nx;
            if (og + 1u == (tg + 1u) * nx) xb_add(&bar[XB_TOPGEN], 1u);
            else XB_SPIN(xb_ld(&bar[XB_TOPGEN]) == tg, bar);
            __builtin_amdgcn_fence(__ATOMIC_ACQUIRE, "agent");
            xb_add(&bar[XB_XGEN(b.x)], 1u);
            asm volatile("s_waitcnt vmcnt(0)" ::: "memory");
        } else {
            XB_SPIN(xb_ld(&bar[XB_XGEN(b.x)]) == gen, bar);
            __builtin_amdgcn_fence(__ATOMIC_ACQUIRE, "agent");
            asm volatile("s_waitcnt vmcnt(0)" ::: "memory");
        }
    }
    __syncthreads();
}

namespace pg8 {
constexpr int BM = 256, BK = 64, HALF = 128, HTB = HALF * BK * 2, STAGE_BYTES = 8 * HTB, NXCD = 8, WGM = 8;
__device__ __forceinline__ int lds_byte(int r, int c) { const int st = (r >> 4) * 2 + (c >> 5), rr = r & 15, cc = c & 31, ob = rr * 64 + cc * 2; return st * 1024 + (ob ^ (((ob >> 9) & 1) << 5)); }
__device__ __forceinline__ void stage_rc(int b, int& R, int& C) { const int st = b / 1024, sb = b % 1024, swz = sb ^ (((sb >> 9) & 1) << 5); R = (st >> 1) * 16 + swz / 64; C = (st & 1) * 32 + (swz % 64) / 2; }
__device__ __forceinline__ int perm32(int rho) { const int n = rho >> 4, i = rho & 15; return 8 * (i >> 2) + 4 * n + (i & 3); }

struct Unit { int pm, pn, g; const char* A; const char* B; };

struct StaticOrder {
    int nM, nN, nwg, G, c; const char* A; const char* B; unsigned tA, tB;
    __device__ void init(int M, int N, int G_, int c_, const void* A_, const void* B_, int lda, int ldb) { nM = M / BM; nN = N / BM; nwg = nM * nN; G = G_; c = c_; A = (const char*)A_; B = (const char*)B_; tA = (unsigned)(BM * lda * 2); tB = (unsigned)(BM * ldb * 2); }
    __device__ bool next(int i, Unit& u) const {
        const long L = (long)i * G + c; if (L >= nwg) return false;
        int wgid = (int)L; { const int q = nwg / NXCD, r = nwg % NXCD, xcd = wgid % NXCD, off = wgid / NXCD; wgid = (xcd < r ? xcd * (q + 1) : r * (q + 1) + (xcd - r) * q) + off; }
        const int nig = WGM * nN, gid = wgid / nig, fm = gid * WGM, gsz = (nM - fm) < WGM ? (nM - fm) : WGM;
        u.pm = fm + ((wgid % nig) % gsz); u.pn = (wgid % nig) / gsz; u.g = 0; u.A = A + (size_t)u.pm * tA; u.B = B + (size_t)u.pn * tB; return true;
    }
};
struct GroupOrder {
    int nwg, G, c, tM, tN; const char* A; const char* B; unsigned sA, sB, tA, tB;
    __device__ void init(int ngrp, int tM_, int tN_, int G_, int c_, const void* A_, const void* B_, int lda, int ldb, size_t sA_, size_t sB_) { tM = tM_; tN = tN_; nwg = ngrp * tM * tN; G = G_; c = c_; A = (const char*)A_; B = (const char*)B_; sA = (unsigned)sA_; sB = (unsigned)sB_; tA = (unsigned)(BM * lda * 2); tB = (unsigned)(BM * ldb * 2); }
    __device__ bool next(int i, Unit& u) const {
        const long L = (long)i * G + c; if (L >= nwg) return false;
        const int per = tM * tN, g = (int)L / per, r = (int)L % per; u.g = g; u.pm = r % tM; u.pn = r / tM;
        u.A = A + (size_t)g * sA + (size_t)u.pm * tA; u.B = B + (size_t)g * sB + (size_t)u.pn * tB; return true;
    }
};

struct PanelOrder {
    int c; const char* A; const char* B; unsigned tA, tB;
    __device__ void init(int c_, const void* A_, const void* B_, int lda, int ldb) { c = c_; A = (const char*)A_; B = (const char*)B_; tA = (unsigned)(BM * lda * 2); tB = (unsigned)(BM * ldb * 2); }
    __device__ bool next(int i, Unit& u) const {
        if (i >= 2) return false;
        const int x = c & 7, j = c >> 3; u.pn = j & 7; u.pm = i * 32 + x * 4 + (j >> 3); u.g = 0; u.A = A + (size_t)u.pm * tA; u.B = B + (size_t)u.pn * tB; return true;
    }
};

template <bool SP2 = true, class Epi, class Sched>
__device__ __forceinline__ void gemm_phase(LAS unsigned char* lds, const int K, const int lda, const int ldb, const Sched& S, const Epi& E) {
    const int tid = opaque_tid(), wid = __builtin_amdgcn_readfirstlane(tid >> 6), lane = tid & 63, wr = wid >> 2, wc = wid & 3, fr = lane & 15, fq = lane >> 4;
    const int nt = K / BK;
    unsigned voffA[2], voffB[2];
#pragma unroll
    for (int i = 0; i < 2; ++i) { int R, C; stage_rc(tid * 16 + i * 8192, R, C); const int Rb = (R & ~31) + perm32(R & 31);
        voffA[i] = (unsigned)(R * lda + C) * 2u; voffB[i] = (unsigned)(Rb * ldb + C) * 2u; }
    constexpr unsigned kstep = (unsigned)(BK * 2);
    const unsigned hstepA = (unsigned)(HALF * lda * 2), hstepB = (unsigned)(HALF * ldb * 2);
    const unsigned ldsw = (unsigned)wid * 1024u;
    const int aoff = lds_byte(wr * 64 + fr, fq * 8), boff = lds_byte(wc * 32 + fr, fq * 8);
#define PG8_SA(b, h) (((b) * 2 + (h)) * HTB)
#define PG8_SB(b, h) ((4 + (b) * 2 + (h)) * HTB)
#define PG8_STAGE(bufoff, gbase, voff) do { _Pragma("unroll") for (int _i = 0; _i < 2; ++_i) \
        __builtin_amdgcn_global_load_lds((const unsigned*)((const char*)(gbase) + (voff)[_i]), (LAS unsigned*)(lds + (bufoff) + ldsw + _i * 8192), 16, 0, 0); } while (0)
#define PG8_LDA(dst, b, h) do { _Pragma("unroll") for (int m = 0; m < 4; ++m) _Pragma("unroll") for (int k = 0; k < 2; ++k) dst[m][k] = *(const LAS bf16x8*)(lds + PG8_SA(b, h) + aoff + m * 2048 + k * 1024); } while (0)
#define PG8_LDB(dst, b, h) do { _Pragma("unroll") for (int n = 0; n < 2; ++n) _Pragma("unroll") for (int k = 0; k < 2; ++k) dst[n][k] = *(const LAS bf16x8*)(lds + PG8_SB(b, h) + boff + n * 2048 + k * 1024); } while (0)
#define PG8_MMA(ai, bj, At, Bt) do { __builtin_amdgcn_s_setprio(1); _Pragma("unroll") for (int m = 0; m < 4; ++m) _Pragma("unroll") for (int n = 0; n < 2; ++n) _Pragma("unroll") for (int k = 0; k < 2; ++k) \
        acc[ai][bj][m][n] = __builtin_amdgcn_mfma_f32_16x16x32_bf16(Bt[n][k], At[m][k], acc[ai][bj][m][n], 0, 0, 0); __builtin_amdgcn_s_setprio(0); } while (0)
#define PG8_WAIT_V(n) asm volatile("s_waitcnt vmcnt(" #n ")" ::: "memory")
#define PG8_WAIT_L(n) asm volatile("s_waitcnt lgkmcnt(" #n ")" ::: "memory")
#define PG8_BAR __builtin_amdgcn_s_barrier()
#define PG8_SCHED __builtin_amdgcn_sched_barrier(0)
    Unit cur, nxt; int ui = 0;
    if (!S.next(0, cur)) return;
    f32x4 acc[2][2][4][2];
#pragma unroll
    for (int a = 0; a < 2; ++a)
#pragma unroll
        for (int b = 0; b < 2; ++b)
#pragma unroll
            for (int m = 0; m < 4; ++m)
#pragma unroll
                for (int n = 0; n < 2; ++n) acc[a][b][m][n] = (f32x4){0.f, 0.f, 0.f, 0.f};
    bf16x8 At[4][2], B0[2][2], B1[2][2];
    const char* cA = cur.A; const char* cB = cur.B;
    if constexpr (SP2) {
    PG8_STAGE(PG8_SB(0, 0), cB, voffB); PG8_STAGE(PG8_SB(0, 1), cB + hstepB, voffB); PG8_STAGE(PG8_SA(0, 0), cA, voffA); PG8_STAGE(PG8_SA(0, 1), cA + hstepA, voffA);
    if (wr == 1) PG8_BAR;
    PG8_WAIT_V(2); PG8_BAR;
    PG8_STAGE(PG8_SB(1, 0), cB + kstep, voffB); PG8_STAGE(PG8_SA(1, 0), cA + kstep, voffA); PG8_STAGE(PG8_SB(1, 1), cB + hstepB + kstep, voffB);
    PG8_WAIT_V(6); PG8_BAR;
    } else {
    PG8_STAGE(PG8_SB(0, 0), cB, voffB); PG8_STAGE(PG8_SA(0, 0), cA, voffA); PG8_STAGE(PG8_SB(0, 1), cB + hstepB, voffB); PG8_STAGE(PG8_SA(0, 1), cA + hstepA, voffA);
    if (wr == 1) PG8_BAR;
    PG8_WAIT_V(4); PG8_BAR;
    PG8_STAGE(PG8_SB(1, 0), cB + kstep, voffB); PG8_STAGE(PG8_SA(1, 0), cA + kstep, voffA); PG8_STAGE(PG8_SB(1, 1), cB + hstepB + kstep, voffB);
    PG8_WAIT_V(6); PG8_BAR;
    }
    for (;;) {
        const bool has_next = S.next(ui + 1, nxt);
        const char* nA = has_next ? nxt.A : cA; const char* nB = has_next ? nxt.B : cB;
        for (int t = 0; t < nt; t += 2) {
            const bool last = (t == nt - 2);
            const char* a1 = cA + (unsigned)(t + 1) * kstep;
            const char* a2 = last ? nA : cA + (unsigned)(t + 2) * kstep; const char* b2 = last ? nB : cB + (unsigned)(t + 2) * kstep;
            const char* a3 = a2 + kstep; const char* b3 = b2 + kstep;
            if constexpr (SP2) {
            PG8_LDB(B0, 0, 0); PG8_LDB(B1, 0, 1); PG8_SCHED; PG8_LDA(At, 0, 0); PG8_STAGE(PG8_SA(1, 1), a1 + hstepA, voffA);
            PG8_WAIT_V(8); PG8_WAIT_L(0); PG8_BAR; PG8_MMA(0, 0, At, B0); PG8_MMA(0, 1, At, B1); PG8_BAR; PG8_SCHED;
            PG8_LDA(At, 0, 1); PG8_STAGE(PG8_SB(0, 0), b2, voffB); PG8_STAGE(PG8_SB(0, 1), b2 + hstepB, voffB); PG8_STAGE(PG8_SA(0, 0), a2, voffA);
            PG8_WAIT_V(8); PG8_WAIT_L(0); PG8_BAR; PG8_MMA(1, 0, At, B0); PG8_MMA(1, 1, At, B1); PG8_BAR; PG8_SCHED;
            PG8_LDB(B0, 1, 0); PG8_LDB(B1, 1, 1); PG8_SCHED; PG8_LDA(At, 1, 0); PG8_STAGE(PG8_SA(0, 1), a2 + hstepA, voffA);
            PG8_WAIT_V(8); PG8_WAIT_L(0); PG8_BAR; PG8_MMA(0, 0, At, B0); PG8_MMA(0, 1, At, B1); PG8_BAR; PG8_SCHED;
            PG8_LDA(At, 1, 1); PG8_STAGE(PG8_SB(1, 0), b3, voffB); PG8_STAGE(PG8_SB(1, 1), b3 + hstepB, voffB); PG8_STAGE(PG8_SA(1, 0), a3, voffA);
            PG8_WAIT_V(8); PG8_WAIT_L(0); PG8_BAR; PG8_MMA(1, 0, At, B0); PG8_MMA(1, 1, At, B1); PG8_BAR; PG8_SCHED;
            } else {
            PG8_LDB(B0, 0, 0); PG8_SCHED; PG8_LDA(At, 0, 0); PG8_STAGE(PG8_SA(1, 1), a1 + hstepA, voffA);
            PG8_WAIT_L(8); PG8_BAR; PG8_WAIT_L(0); PG8_MMA(0, 0, At, B0); PG8_BAR; PG8_SCHED;
            PG8_LDB(B1, 0, 1); PG8_STAGE(PG8_SB(0, 0), b2, voffB);
            PG8_BAR; PG8_WAIT_L(0); PG8_MMA(0, 1, At, B1); PG8_BAR;
            PG8_LDA(At, 0, 1); PG8_STAGE(PG8_SA(0, 0), a2, voffA);
            PG8_BAR; PG8_WAIT_L(0); PG8_MMA(1, 0, At, B0); PG8_BAR; PG8_SCHED;
            PG8_STAGE(PG8_SB(0, 1), b2 + hstepB, voffB);
            PG8_WAIT_V(6); PG8_BAR; PG8_MMA(1, 1, At, B1); PG8_BAR;
            PG8_LDB(B0, 1, 0); PG8_SCHED; PG8_LDA(At, 1, 0); PG8_STAGE(PG8_SA(0, 1), a2 + hstepA, voffA);
            PG8_WAIT_L(8); PG8_BAR; PG8_WAIT_L(0); PG8_MMA(0, 0, At, B0); PG8_BAR; PG8_SCHED;
            PG8_LDB(B1, 1, 1); PG8_STAGE(PG8_SB(1, 0), b3, voffB);
            PG8_BAR; PG8_WAIT_L(0); PG8_MMA(0, 1, At, B1); PG8_BAR;
            PG8_LDA(At, 1, 1); PG8_STAGE(PG8_SA(1, 0), a3, voffA);
            PG8_BAR; PG8_WAIT_L(0); PG8_MMA(1, 0, At, B0); PG8_BAR; PG8_SCHED;
            PG8_STAGE(PG8_SB(1, 1), b3 + hstepB, voffB);
            PG8_WAIT_V(6); PG8_BAR; PG8_MMA(1, 1, At, B1); PG8_BAR;
            }
        }
        if (wr == 0) PG8_BAR;
        if constexpr (Epi::FUSED) E.fused(acc, cur, wr, wc, fr, fq, lds, tid); else E(acc, cur, wr, wc, fr, fq);
        if (!has_next) break;
#pragma unroll
        for (int a = 0; a < 2; ++a)
#pragma unroll
            for (int b = 0; b < 2; ++b)
#pragma unroll
                for (int m = 0; m < 4; ++m)
#pragma unroll
                    for (int n = 0; n < 2; ++n) acc[a][b][m][n] = (f32x4){0.f, 0.f, 0.f, 0.f};
        cur = nxt; cA = nA; cB = nB; ++ui;
        if (wr == 1) PG8_BAR;
    }
    PG8_WAIT_V(0);
    PG8_BAR;
#undef PG8_SA
#undef PG8_SB
#undef PG8_STAGE
#undef PG8_LDA
#undef PG8_LDB
#undef PG8_MMA
#undef PG8_WAIT_V
#undef PG8_WAIT_L
#undef PG8_BAR
#undef PG8_SCHED
}
}
using pg8::Unit;
typedef f32x4 AccT[2][2][4][2];

struct EpiInProj {
    static constexpr bool FUSED = false;
    unsigned char* ws;
    __device__ __forceinline__ void operator()(const AccT& acc, const Unit& u, int wr, int wc, int fr, int fq) const {
        bf16_t* PROJ = (bf16_t*)(ws + WS_PROJ); bf16_t* ACOMB = (bf16_t*)(ws + WS_ACOMB); const float* ROT = (const float*)(ws + WS_ROT);
        const int colt = u.pn * 256, region = colt >> 10;
        if (region < 2) {
            const float qs = (region == 0) ? QSCALE : 1.0f;
            const bool rotl = ((wc & 1) == 0) && (fq < 2);
            const float sg = (fq == 0) ? -1.0f : 1.0f;
#pragma unroll
            for (int ai = 0; ai < 2; ++ai)
#pragma unroll
                for (int m = 0; m < 4; ++m) {
                    const int row = u.pm * 256 + ai * 128 + wr * 64 + m * 16 + fr;
                    const f32x4* rt = (const f32x4*)(ROT + (size_t)row * 16);
                    const f32x4 c0 = rt[0], c1 = rt[1], s0 = rt[2], s1 = rt[3];
#pragma unroll
                    for (int bj = 0; bj < 2; ++bj) {
                        const int col0 = colt + bj * 128 + wc * 32 + 8 * fq;
                        f32x4 v0 = acc[ai][bj][m][0], v1 = acc[ai][bj][m][1];
                        f32x4 p0, p1;
#pragma unroll
                        for (int e = 0; e < 4; ++e) { p0[e] = __shfl_xor(v0[e], 16); p1[e] = __shfl_xor(v1[e], 16); }
                        const f32x4 r0 = v0 * c0 + sg * (p0 * s0), r1 = v1 * c1 + sg * (p1 * s1);
                        v0 = rotl ? r0 : v0; v1 = rotl ? r1 : v1;
                        v0 = v0 * qs; v1 = v1 * qs;
                        u32x4 w; w.x = cvt_pk_bf16(v0[0], v0[1]); w.y = cvt_pk_bf16(v0[2], v0[3]); w.z = cvt_pk_bf16(v1[0], v1[1]); w.w = cvt_pk_bf16(v1[2], v1[3]);
                        *(u32x4*)(PROJ + (size_t)row * PP + col0) = w;
                    }
                    if (m & 1) asm volatile("" ::: "memory");
                }
        } else {
#pragma unroll
            for (int ai = 0; ai < 2; ++ai)
#pragma unroll
                for (int m = 0; m < 4; ++m) {
                    const int row = u.pm * 256 + ai * 128 + wr * 64 + m * 16 + fr;
#pragma unroll
                    for (int bj = 0; bj < 2; ++bj) {
                        const int col0 = colt + bj * 128 + wc * 32 + 8 * fq;
                        const f32x4 v0 = acc[ai][bj][m][0], v1 = acc[ai][bj][m][1];
                        u32x4 w; w.x = cvt_pk_bf16(v0[0], v0[1]); w.y = cvt_pk_bf16(v0[2], v0[3]); w.z = cvt_pk_bf16(v1[0], v1[1]); w.w = cvt_pk_bf16(v1[2], v1[3]);
                        if (region == 4) {
                            const int uc = col0 - 4096, g = uc >> 4, s0 = uc & 15;
                            *(u32x4*)(ACOMB + ((size_t)g * RG + (row >> 5)) * KA + (row & 31) * 16 + s0) = w;
                        } else {
                            const int pc = (region == 5) ? col0 - 1024 : col0;
                            *(u32x4*)(PROJ + (size_t)row * PP + pc) = w;
                        }
                    }
                    asm volatile("" ::: "memory");
                }
        }
    }
};
struct EpiS1 {
    static constexpr bool FUSED = false;
    float* SBUF;
    __device__ __forceinline__ void operator()(const AccT& acc, const Unit& u, int wr, int wc, int fr, int fq) const {
#pragma unroll
        for (int ai = 0; ai < 2; ++ai)
#pragma unroll
            for (int m = 0; m < 4; ++m) {
                const int row = u.pm * 256 + ai * 128 + wr * 64 + m * 16 + fr;
                float* rp = SBUF + ((size_t)u.g * RG + row) * 256 + u.pn * 256 + wc * 32 + 8 * fq;
#pragma unroll
                for (int bj = 0; bj < 2; ++bj) { *(f32x4*)(rp + bj * 128) = acc[ai][bj][m][0]; *(f32x4*)(rp + bj * 128 + 4) = acc[ai][bj][m][1]; }
            }
    }
};
struct EpiS3 {
    static constexpr bool FUSED = false;
    bf16_t* YG;
    __device__ __forceinline__ void operator()(const AccT& acc, const Unit& u, int wr, int wc, int fr, int fq) const {
#pragma unroll
        for (int ai = 0; ai < 2; ++ai)
#pragma unroll
            for (int m = 0; m < 4; ++m) {
                const int rg = u.pm * 256 + ai * 128 + wr * 64 + m * 16 + fr;
#pragma unroll
                for (int bj = 0; bj < 2; ++bj) {
                    const int nc = u.pn * 256 + bj * 128 + wc * 32 + 8 * fq, i = nc >> 4, s0 = nc & 15;
                    const f32x4 v0 = acc[ai][bj][m][0], v1 = acc[ai][bj][m][1];
                    u32x4 w; w.x = cvt_pk_bf16(gelu_tanh_f(v0[0]), gelu_tanh_f(v0[1])); w.y = cvt_pk_bf16(gelu_tanh_f(v0[2]), gelu_tanh_f(v0[3]));
                    w.z = cvt_pk_bf16(gelu_tanh_f(v1[0]), gelu_tanh_f(v1[1])); w.w = cvt_pk_bf16(gelu_tanh_f(v1[2]), gelu_tanh_f(v1[3]));
                    *(u32x4*)(YG + ((size_t)rg * 32 + i) * 1024 + u.g * 16 + s0) = w;
                }
            }
    }
};
struct EpiGLU {
    static constexpr bool FUSED = false;
    unsigned char* ws; const float* bglu;
    __device__ __forceinline__ void operator()(const AccT& acc, const Unit& u, int wr, int wc, int fr, int fq) const {
        bf16_t* OCAT = (bf16_t*)(ws + WS_H); const bf16_t* PROJ = (const bf16_t*)(ws + WS_PROJ);
        const int lc = u.pn * 128 + wc * 32 + 8 * fq;
        const f32x4 bl0 = *(const f32x4*)(bglu + lc), bl1 = *(const f32x4*)(bglu + lc + 4), bg0 = *(const f32x4*)(bglu + 1024 + lc), bg1 = *(const f32x4*)(bglu + 1024 + lc + 4);
#pragma unroll
        for (int ai = 0; ai < 2; ++ai)
#pragma unroll
            for (int m = 0; m < 4; ++m) {
                const int row = u.pm * 256 + ai * 128 + wr * 64 + m * 16 + fr;
                const u32x4 z = *(const u32x4*)(PROJ + (size_t)row * PP + C_ZS + lc);
                const f32x4 l0 = acc[ai][0][m][0] + bl0, l1 = acc[ai][0][m][1] + bl1, g0 = acc[ai][1][m][0] + bg0, g1 = acc[ai][1][m][1] + bg1;
                float o[8];
                o[0] = l0[0] * sigmoid_f(g0[0]) * silu_f(bflo(z.x)); o[1] = l0[1] * sigmoid_f(g0[1]) * silu_f(bfhi(z.x));
                o[2] = l0[2] * sigmoid_f(g0[2]) * silu_f(bflo(z.y)); o[3] = l0[3] * sigmoid_f(g0[3]) * silu_f(bfhi(z.y));
                o[4] = l1[0] * sigmoid_f(g1[0]) * silu_f(bflo(z.z)); o[5] = l1[1] * sigmoid_f(g1[1]) * silu_f(bfhi(z.z));
                o[6] = l1[2] * sigmoid_f(g1[2]) * silu_f(bflo(z.w)); o[7] = l1[3] * sigmoid_f(g1[3]) * silu_f(bfhi(z.w));
                u32x4 w; w.x = cvt_pk_bf16(o[0], o[1]); w.y = cvt_pk_bf16(o[2], o[3]); w.z = cvt_pk_bf16(o[4], o[5]); w.w = cvt_pk_bf16(o[6], o[7]);
                *(u32x4*)(OCAT + (size_t)row * 2048 + 1024 + lc) = w;
                if (m == 3) asm volatile("" ::: "memory");
            }
    }
};
struct EpiOut {
    static constexpr bool FUSED = false;
    const float* xold; float* xnew; const float* gate;
    __device__ __forceinline__ void operator()(const AccT& acc, const Unit& u, int wr, int wc, int fr, int fq) const {
        const int bb = u.pm >> 3;
#pragma unroll
        for (int bj = 0; bj < 2; ++bj) {
            const int col0 = u.pn * 256 + bj * 128 + wc * 32 + 8 * fq;
            const f32x4 gt0 = *(const f32x4*)(gate + (size_t)bb * 6144 + col0), gt1 = *(const f32x4*)(gate + (size_t)bb * 6144 + col0 + 4);
#pragma unroll
            for (int ai = 0; ai < 2; ++ai)
#pragma unroll
                for (int m = 0; m < 4; ++m) {
                    const size_t off = (size_t)(u.pm * 256 + ai * 128 + wr * 64 + m * 16 + fr) * DM + col0;
                    const f32x4 x0 = *(const f32x4*)(xold + off), x1 = *(const f32x4*)(xold + off + 4);
                    *(f32x4*)(xnew + off) = x0 + gt0 * acc[ai][bj][m][0]; *(f32x4*)(xnew + off + 4) = x1 + gt1 * acc[ai][bj][m][1];
                    asm volatile("" ::: "memory");
                }
        }
    }
};

struct EpiOutNorm {
    static constexpr bool FUSED = true;
    float* OUT; const float* gate; float* rss; unsigned* cnt; const float* g; const float* modn; bf16_t* H; int mode; unsigned char* ws;
    __device__ __forceinline__ bf16_t* x1base(const Unit& u) const { return (bf16_t*)(ws + (u.pm < 48 ? WS_WCAT : WS_WST - (size_t)12288 * 4096)); }
    __device__ __forceinline__ void fused(AccT& acc, const Unit& u, int wr, int wc, int fr, int fq, LAS unsigned char* lds, int tid_unused) const {
        const int tid = opaque_tid();
        LAS float* P = (LAS float*)(lds + 131072);
        LAS float* S = (LAS float*)(lds + 131072 + 4096);
        const int bb = u.pm >> 3;
        bf16_t* const x1b = x1base(u); const bf16_t* const resb = (mode == 0) ? (const bf16_t*)OUT : (const bf16_t*)x1b;
        float ss[2][4];
#pragma unroll
        for (int ai = 0; ai < 2; ++ai)
#pragma unroll
            for (int m = 0; m < 4; ++m) ss[ai][m] = 0.f;
#pragma unroll
        for (int bj = 0; bj < 2; ++bj) {
            const int col0 = u.pn * 256 + bj * 128 + wc * 32 + 8 * fq;
            const f32x4 gt0 = *(const f32x4*)(gate + (size_t)bb * 6144 + col0), gt1 = *(const f32x4*)(gate + (size_t)bb * 6144 + col0 + 4);
#pragma unroll
            for (int ai = 0; ai < 2; ++ai) {
#pragma unroll
                for (int m = 0; m < 4; ++m) {
                    const int row_ = u.pm * 256 + ai * 128 + wr * 64 + m * 16 + fr;
                    const u32x4 xb = *(const u32x4*)(resb + (size_t)row_ * DM + col0);
                    const f32x4 x0 = (f32x4){bflo(xb.x), bfhi(xb.x), bflo(xb.y), bfhi(xb.y)}, x1 = (f32x4){bflo(xb.z), bfhi(xb.z), bflo(xb.w), bfhi(xb.w)};
                    const f32x4 v0 = x0 + gt0 * acc[ai][bj][m][0], v1 = x1 + gt1 * acc[ai][bj][m][1];
                    acc[ai][bj][m][0] = v0; acc[ai][bj][m][1] = v1;
                    ss[ai][m] += (v0[0] * v0[0] + v0[1] * v0[1]) + (v0[2] * v0[2] + v0[3] * v0[3]) + (v1[0] * v1[0] + v1[1] * v1[1]) + (v1[2] * v1[2] + v1[3] * v1[3]);
                    if (m & 1) asm volatile("" ::: "memory");
                }
            }
        }
#pragma unroll
        for (int ai = 0; ai < 2; ++ai)
#pragma unroll
            for (int m = 0; m < 4; ++m) { float v = ss[ai][m]; v += __shfl_xor(v, 16); v += __shfl_xor(v, 32); if (fq == 0) P[(ai * 128 + wr * 64 + m * 16 + fr) * 4 + wc] = v; }
        asm volatile("s_waitcnt lgkmcnt(0)" ::: "memory"); __builtin_amdgcn_s_barrier(); asm volatile("" ::: "memory");
        if (tid < 256) { const f32x4 p = *(const LAS f32x4*)(P + tid * 4);
            (void)__hip_atomic_fetch_add(rss + u.pm * 256 + tid, (p[0] + p[1]) + (p[2] + p[3]), __ATOMIC_RELAXED, __HIP_MEMORY_SCOPE_AGENT); }
        asm volatile("s_waitcnt vmcnt(0)" ::: "memory"); __builtin_amdgcn_s_barrier(); asm volatile("" ::: "memory");
        if (tid < 64) {
            if (tid == 0) (void)__hip_atomic_fetch_add(cnt + u.pm * 64, 1u, __ATOMIC_RELAXED, __HIP_MEMORY_SCOPE_AGENT);
            unsigned sp = 0;
            while ((unsigned)__builtin_amdgcn_readfirstlane(__hip_atomic_load(cnt + u.pm * 64, __ATOMIC_RELAXED, __HIP_MEMORY_SCOPE_AGENT)) < 8u) { __builtin_amdgcn_s_sleep(2); if (++sp > (1u << 22)) break; }
        }
        asm volatile("s_waitcnt vmcnt(0) lgkmcnt(0)" ::: "memory"); __builtin_amdgcn_s_barrier(); asm volatile("" ::: "memory");
        if (tid < 256) { const float t = __hip_atomic_load(rss + u.pm * 256 + tid, __ATOMIC_RELAXED, __HIP_MEMORY_SCOPE_AGENT); S[tid] = rsqrtf(t * (1.0f / DM) + EPS); }
        asm volatile("s_waitcnt vmcnt(0) lgkmcnt(0)" ::: "memory"); __builtin_amdgcn_s_barrier(); asm volatile("" ::: "memory");
#pragma unroll
        for (int bj = 0; bj < 2; ++bj) {
            const int col0 = u.pn * 256 + bj * 128 + wc * 32 + 8 * fq;
            f32x4 w0 = *(const f32x4*)(g + col0), w1 = *(const f32x4*)(g + col0 + 4), a0 = {0.f, 0.f, 0.f, 0.f}, a1 = a0;
            if (mode == 0) { const float* sh = modn + (size_t)bb * 6144; a0 = *(const f32x4*)(sh + col0); a1 = *(const f32x4*)(sh + col0 + 4);
                w0 = w0 * (1.0f + *(const f32x4*)(sh + 2048 + col0)); w1 = w1 * (1.0f + *(const f32x4*)(sh + 2048 + col0 + 4)); }
#pragma unroll
            for (int ai = 0; ai < 2; ++ai)
#pragma unroll
                for (int m = 0; m < 4; ++m) {
                    const int r = ai * 128 + wr * 64 + m * 16 + fr; const float rs = S[r];
                    const size_t off = (size_t)(u.pm * 256 + r) * DM + col0;
                    const f32x4 v0 = acc[ai][bj][m][0], v1 = acc[ai][bj][m][1];
                    const f32x4 o0 = v0 * rs * w0 + a0, o1 = v1 * rs * w1 + a1;
                    if (mode == 0) {
                        u32x4 xw; xw.x = cvt_pk_bf16(v0[0], v0[1]); xw.y = cvt_pk_bf16(v0[2], v0[3]); xw.z = cvt_pk_bf16(v1[0], v1[1]); xw.w = cvt_pk_bf16(v1[2], v1[3]); *(u32x4*)(x1b + off) = xw;
                        u32x4 w; w.x = cvt_pk_bf16(o0[0], o0[1]); w.y = cvt_pk_bf16(o0[2], o0[3]); w.z = cvt_pk_bf16(o1[0], o1[1]); w.w = cvt_pk_bf16(o1[2], o1[3]); *(u32x4*)(H + off) = w;
                    } else { *(f32x4*)(OUT + off) = o0; *(f32x4*)(OUT + off + 4) = o1; }
                    asm volatile("" ::: "memory");
                }
        }
        asm volatile("s_waitcnt lgkmcnt(0)" ::: "memory"); __builtin_amdgcn_s_barrier(); asm volatile("" ::: "memory");
    }
};

__device__ __forceinline__ void transpose_item(const float* W, int K, int N, bf16_t* WT, int k0, int n0, int rowbase, LAS float* scr, int lane) {
#pragma unroll
    for (int i = 0; i < 32; ++i) { const int kk = 2 * i + (lane >> 5); scr[kk * 33 + (lane & 31)] = W[(size_t)(k0 + kk) * N + n0 + (lane & 31)]; }
    asm volatile("s_waitcnt lgkmcnt(0)" ::: "memory");
    const int c = lane & 7;
#pragma unroll
    for (int j = 0; j < 4; ++j) { const int n = (lane >> 3) + 8 * j; const LAS float* s = scr + (8 * c) * 33 + n;
        u32x4 o; o.x = pk2(s[0 * 33], s[1 * 33]); o.y = pk2(s[2 * 33], s[3 * 33]); o.z = pk2(s[4 * 33], s[5 * 33]); o.w = pk2(s[6 * 33], s[7 * 33]);
        *(u32x4*)(WT + (size_t)(rowbase + n) * K + k0 + 8 * c) = o; }
    asm volatile("s_waitcnt lgkmcnt(0)" ::: "memory");
}

__device__ __forceinline__ void mod_item(int item, const float* w_ada, const float* b_ada, float* mod, LAS unsigned char* lds, int tid) {
    const int layer = item / 96, col0 = (item % 96) * 64, quad = tid & 15, ks = tid >> 4;
    const LAS float* cond = (const LAS float*)lds; LAS float* red = (LAS float*)(lds + 65536);
    const float* wp = w_ada + ((size_t)layer * 2048 + ks * 64) * 6144 + col0 + quad * 4;
    f32x4 a0 = {0, 0, 0, 0}, a1 = a0, a2 = a0, a3 = a0, a4 = a0, a5 = a0, a6 = a0, a7 = a0;
#pragma unroll 8
    for (int kk = 0; kk < 64; ++kk) {
        const f32x4 w = *(const f32x4*)(wp + (size_t)kk * 6144);
        const f32x4 c0 = *(const LAS f32x4*)(cond + (ks * 64 + kk) * 8), c1 = *(const LAS f32x4*)(cond + (ks * 64 + kk) * 8 + 4);
        a0 += c0[0] * w; a1 += c0[1] * w; a2 += c0[2] * w; a3 += c0[3] * w; a4 += c1[0] * w; a5 += c1[1] * w; a6 += c1[2] * w; a7 += c1[3] * w;
    }
    LAS float* rp = red + (ks * 8) * 64 + quad * 4;
    *(LAS f32x4*)(rp + 0 * 64) = a0; *(LAS f32x4*)(rp + 1 * 64) = a1; *(LAS f32x4*)(rp + 2 * 64) = a2; *(LAS f32x4*)(rp + 3 * 64) = a3;
    *(LAS f32x4*)(rp + 4 * 64) = a4; *(LAS f32x4*)(rp + 5 * 64) = a5; *(LAS f32x4*)(rp + 6 * 64) = a6; *(LAS f32x4*)(rp + 7 * 64) = a7;
    __syncthreads();
    { const int b = tid >> 6, col = tid & 63; float s = 0.f;
#pragma unroll 8
      for (int k2 = 0; k2 < 32; ++k2) s += red[(k2 * 8 + b) * 64 + col];
      mod[((size_t)layer * 8 + b) * 6144 + col0 + col] = s + b_ada[(size_t)layer * 6144 + col0 + col]; }
    __syncthreads();
}

struct SsmIn { const float *a_re, *a_im, *log_dt, *b_re, *b_im, *c_re, *c_im, *d_skip; };
__device__ __forceinline__ void ssm_gen_item(int layer, int g, int half, const SsmIn& in, bf16_t* WCAT, bf16_t* WST, float* lamT, LAS unsigned char* lds, int tid) {
    LAS float* Ere = (LAS float*)lds;
    LAS float* Eim = Ere + 2 * 64 * 36;
    LAS float* Fr = Eim + 2 * 64 * 36;
    LAS float* Fi = Fr + 128;
    LAS float* BBr = Fi + 128;
    LAS float* BBi = BBr + 2 * 64 * 16;
    LAS float* Cr = BBi + 2 * 64 * 16;
    LAS float* Ci = Cr + 2 * 16 * 64;
    LAS float* Kc = Ci + 2 * 16 * 64;
    LAS float* Dsk = Kc + 64 * 260;
    {
        const int d = tid >> 8, q = tid & 255; const size_t gi = ((size_t)(layer * 2 + d) * NGRP + g) * 1024 + q * 4;
        *(LAS f32x4*)(BBr + d * 1024 + q * 4) = *(const f32x4*)(in.b_re + gi); *(LAS f32x4*)(BBi + d * 1024 + q * 4) = *(const f32x4*)(in.b_im + gi);
        *(LAS f32x4*)(Cr + d * 1024 + q * 4) = *(const f32x4*)(in.c_re + gi); *(LAS f32x4*)(Ci + d * 1024 + q * 4) = *(const f32x4*)(in.c_im + gi);
        if (tid < 16) Dsk[tid] = in.d_skip[(size_t)layer * 1024 + g * 16 + tid];
    }
    if (tid < 128) {
        const int d = tid >> 6, p = tid & 63;
        const size_t gi = ((size_t)(layer * 2 + d) * NGRP + g);
        const double dt = exp((double)in.log_dt[gi]);
        const double are = (double)in.a_re[gi * 64 + p], aim = (double)in.a_im[gi * 64 + p];
        const double mag = exp(are * dt); double ang = aim * dt;
        ang -= 6.283185307179586476925286766559 * rint(ang * 0.15915494309189533576888376337251);
        const double lr = mag * cos(ang), li = mag * sin(ang);
        const double den = are * are + aim * aim, nr = lr - 1.0, ni = li;
        Fr[tid] = (float)((nr * are + ni * aim) / den); Fi[tid] = (float)((ni * are - nr * aim) / den);
        double er = 1.0, ei = 0.0;
        for (int t = 0; t <= 32; ++t) { Ere[tid * 36 + t] = (float)er; Eim[tid * 36 + t] = (float)ei; const double tr = er * lr - ei * li, ti = er * li + ei * lr; er = tr; ei = ti; }
        if (half == 0) { lamT[((size_t)(g * 2 + d) * 64 + p) * 2 + 0] = Ere[tid * 36 + 32]; lamT[((size_t)(g * 2 + d) * 64 + p) * 2 + 1] = Eim[tid * 36 + 32]; }
    }
    __syncthreads();
    {
        const int dp = tid >> 2, sq = (tid & 3) * 4; const float fr = Fr[dp], fi = Fi[dp];
        const f32x4 br = *(const LAS f32x4*)(BBr + dp * 16 + sq), bi = *(const LAS f32x4*)(BBi + dp * 16 + sq);
        *(LAS f32x4*)(BBr + dp * 16 + sq) = fr * br - fi * bi; *(LAS f32x4*)(BBi + dp * 16 + sq) = fr * bi + fi * br;
    }
    __syncthreads();
    {
        const int d = tid >> 8, tb = (tid >> 6) & 3, sp = (tid >> 2) & 15, sb = tid & 3;
        f32x4 acc[8];
#pragma unroll
        for (int t = 0; t < 8; ++t) acc[t] = (f32x4){0.f, 0.f, 0.f, 0.f};
        for (int p = 0; p < 64; ++p) {
            const float cr = Cr[(d * 16 + sp) * 64 + p], ci = Ci[(d * 16 + sp) * 64 + p];
            const f32x4 br = *(const LAS f32x4*)(BBr + (d * 64 + p) * 16 + sb * 4), bi = *(const LAS f32x4*)(BBi + (d * 64 + p) * 16 + sb * 4);
            const f32x4 gr = cr * br - ci * bi, gim = cr * bi + ci * br;
            const f32x4 e0 = *(const LAS f32x4*)(Ere + (d * 64 + p) * 36 + tb * 8), e1 = *(const LAS f32x4*)(Ere + (d * 64 + p) * 36 + tb * 8 + 4);
            const f32x4 i0 = *(const LAS f32x4*)(Eim + (d * 64 + p) * 36 + tb * 8), i1 = *(const LAS f32x4*)(Eim + (d * 64 + p) * 36 + tb * 8 + 4);
            acc[0] += gr * e0[0] - gim * i0[0]; acc[1] += gr * e0[1] - gim * i0[1]; acc[2] += gr * e0[2] - gim * i0[2]; acc[3] += gr * e0[3] - gim * i0[3];
            acc[4] += gr * e1[0] - gim * i1[0]; acc[5] += gr * e1[1] - gim * i1[1]; acc[6] += gr * e1[2] - gim * i1[2]; acc[7] += gr * e1[3] - gim * i1[3];
        }
#pragma unroll
        for (int t = 0; t < 8; ++t) *(LAS f32x4*)(Kc + (d * 32 + tb * 8 + t) * 260 + sp * 16 + sb * 4) = acc[t];
    }
    __syncthreads();
    for (int ch = half * 256 * 96 + tid; ch < (half + 1) * 256 * 96; ch += 512) {
        const int n = ch / 96, kc = ch % 96, i = n >> 4, sp = n & 15, k0 = kc * 8;
        f32x4 va, vb;
        if (k0 < 512) {
            const int j = k0 >> 4, s0 = k0 & 15;
            if (i != j) {
                const int tau = (i > j) ? (i - j) : (32 + (j - i));
                const LAS float* src = Kc + tau * 260 + sp * 16 + s0;
                va = *(const LAS f32x4*)src; vb = *(const LAS f32x4*)(src + 4);
            } else {
                const LAS float* s0p = Kc + sp * 16 + s0; const LAS float* s1p = Kc + 32 * 260 + sp * 16 + s0;
                va = *(const LAS f32x4*)s0p + *(const LAS f32x4*)s1p; vb = *(const LAS f32x4*)(s0p + 4) + *(const LAS f32x4*)(s1p + 4);
                const int e = sp - s0;
                if (e >= 0 && e < 8) { const float dv = Dsk[sp];
                    if (e == 0) va[0] += dv; else if (e == 1) va[1] += dv; else if (e == 2) va[2] += dv; else if (e == 3) va[3] += dv;
                    else if (e == 4) vb[0] += dv; else if (e == 5) vb[1] += dv; else if (e == 6) vb[2] += dv; else vb[3] += dv; }
            }
        } else {
            const int kk = k0 - 512, d = kk >> 7, ri = (kk >> 6) & 1, p0 = kk & 63, pw = (d == 0) ? (i + 1) : (TCH - i);
            float v[8];
#pragma unroll
            for (int e = 0; e < 8; ++e) {
                const int p = p0 + e;
                const float cr = Cr[(d * 16 + sp) * 64 + p], ci = Ci[(d * 16 + sp) * 64 + p], er = Ere[(d * 64 + p) * 36 + pw], ei = Eim[(d * 64 + p) * 36 + pw];
                v[e] = (ri == 0) ? (cr * er - ci * ei) : -(cr * ei + ci * er);
            }
            va = (f32x4){v[0], v[1], v[2], v[3]}; vb = (f32x4){v[4], v[5], v[6], v[7]};
        }
        u32x4 w; w.x = cvt_pk_bf16(va[0], va[1]); w.y = cvt_pk_bf16(va[2], va[3]); w.z = cvt_pk_bf16(vb[0], vb[1]); w.w = cvt_pk_bf16(vb[2], vb[3]);
        *(u32x4*)(WCAT + ((size_t)g * 512 + n) * KA + k0) = w;
    }
    for (int ch = half * 128 * 64 + tid; ch < (half + 1) * 128 * 64; ch += 512) {
        const int n = ch >> 6, kc = ch & 63, d = n >> 7, ri = (n >> 6) & 1, p = n & 63, k0 = kc * 8, j = k0 >> 4, s0 = k0 & 15, pw = (d == 0) ? (TCH - 1 - j) : j;
        const float er = Ere[(d * 64 + p) * 36 + pw], ei = Eim[(d * 64 + p) * 36 + pw];
        const f32x4 br0 = *(const LAS f32x4*)(BBr + (d * 64 + p) * 16 + s0), br1 = *(const LAS f32x4*)(BBr + (d * 64 + p) * 16 + s0 + 4);
        const f32x4 bi0 = *(const LAS f32x4*)(BBi + (d * 64 + p) * 16 + s0), bi1 = *(const LAS f32x4*)(BBi + (d * 64 + p) * 16 + s0 + 4);
        const f32x4 va = (ri == 0) ? (er * br0 - ei * bi0) : (er * bi0 + ei * br0), vb = (ri == 0) ? (er * br1 - ei * bi1) : (er * bi1 + ei * br1);
        u32x4 w; w.x = cvt_pk_bf16(va[0], va[1]); w.y = cvt_pk_bf16(va[2], va[3]); w.z = cvt_pk_bf16(vb[0], vb[1]); w.w = cvt_pk_bf16(vb[2], vb[3]);
        *(u32x4*)(WST + ((size_t)g * 256 + n) * 512 + k0) = w;
    }
    __syncthreads();
}

__device__ __forceinline__ void s2_phase(const float* SBUF, bf16_t* ACOMB, const float* lamT, int bx, int tid) {
    if (bx >= 128) return;
    const int idx = bx * 512 + tid, p = idx & 63, d = (idx >> 6) & 1, b = (idx >> 7) & 7, g = idx >> 10;
    const float lr = lamT[((size_t)(g * 2 + d) * 64 + p) * 2], li = lamT[((size_t)(g * 2 + d) * 64 + p) * 2 + 1];
    const float* sp = SBUF + ((size_t)g * RG + b * 64) * 256 + d * 128 + p;
    bf16_t* xp = ACOMB + ((size_t)g * RG + b * 64) * KA + 512 + d * 128 + p;
    float xr = 0.f, xi = 0.f;
    for (int blk = 0; blk < 2; ++blk) {
        float sr[32], si[32];
#pragma unroll
        for (int k = 0; k < 32; ++k) { const int c = (d == 0) ? (blk * 32 + k) : (63 - (blk * 32 + k)); sr[k] = sp[(size_t)c * 256]; si[k] = sp[(size_t)c * 256 + 64]; }
#pragma unroll
        for (int k = 0; k < 32; ++k) { const int c = (d == 0) ? (blk * 32 + k) : (63 - (blk * 32 + k));
            xp[(size_t)c * KA] = (bf16_t)f2bf(xr); xp[(size_t)c * KA + 64] = (bf16_t)f2bf(xi);
            const float nr = lr * xr - li * xi + sr[k], ni = lr * xi + li * xr + si[k]; xr = nr; xi = ni; }
    }
}

__device__ __forceinline__ void norm_rows(const float* x, const float* g, const float* modl  , bf16_t* H, float* out, int mode, int gw, int NGW, int lane, bf16_t* xb = nullptr) {
    for (int row = gw; row < MTOK; row += NGW) {
        const f32x4* xr = (const f32x4*)(x + (size_t)row * DM) + lane;
        f32x4 v[8]; float ss = 0.f;
#pragma unroll
        for (int j = 0; j < 8; ++j) { v[j] = xr[64 * j]; ss += (v[j].x * v[j].x + v[j].y * v[j].y) + (v[j].z * v[j].z + v[j].w * v[j].w); }
        const float rstd = rsqrtf(wave_sum(ss) * (1.0f / DM) + EPS);
        if (mode == 0) {
            const int b = row >> 11; const float* sh = modl + (size_t)b * 6144; const float* sc = sh + 2048;
#pragma unroll
            for (int j = 0; j < 8; ++j) { const int col = 4 * lane + 256 * j; const f32x4 gg = *(const f32x4*)(g + col), s1 = *(const f32x4*)(sc + col), s0 = *(const f32x4*)(sh + col);
                const f32x4 h = v[j] * rstd * gg * (1.0f + s1) + s0; u32x2 w; w.x = cvt_pk_bf16(h.x, h.y); w.y = cvt_pk_bf16(h.z, h.w);
                *(u32x2*)(H + (size_t)row * DM + col) = w;
                if (xb) { u32x2 wx; wx.x = cvt_pk_bf16(v[j].x, v[j].y); wx.y = cvt_pk_bf16(v[j].z, v[j].w); *(u32x2*)(xb + (size_t)row * DM + col) = wx; } }
        } else {
#pragma unroll
            for (int j = 0; j < 8; ++j) { const int col = 4 * lane + 256 * j; const f32x4 gg = *(const f32x4*)(g + col); *(f32x4*)(out + (size_t)row * DM + col) = v[j] * rstd * gg; }
        }
    }
}

typedef float f32x2_t __attribute__((ext_vector_type(2)));
typedef __bf16 bf16x2_t __attribute__((ext_vector_type(2)));
__device__ __forceinline__ unsigned cvtpk_s(float lo, float hi) { f32x2_t v = {lo, hi}; bf16x2_t b = __builtin_convertvector(v, bf16x2_t); return __builtin_bit_cast(unsigned, b); }
__device__ __forceinline__ float max3f(float a, float b, float c) { float r; asm("v_max3_f32 %0, %1, %2, %3" : "=v"(r) : "v"(a), "v"(b), "v"(c)); return r; }
__device__ __forceinline__ float max2f(float a, float b) { float r; asm("v_max_f32_e32 %0, %1, %2" : "=v"(r) : "v"(a), "v"(b)); return r; }
__device__ __forceinline__ float half_max(float m) { auto rr = __builtin_amdgcn_permlane32_swap(__float_as_uint(m), __float_as_uint(m), false, false); return max2f(__uint_as_float(rr[0]), __uint_as_float(rr[1])); }
__device__ __forceinline__ float half_sum(float m) { auto rr = __builtin_amdgcn_permlane32_swap(__float_as_uint(m), __float_as_uint(m), false, false); return __uint_as_float(rr[0]) + __uint_as_float(rr[1]); }
#define ATT_SBAR() __builtin_amdgcn_sched_barrier(0)
#define ATT_MFMA(a, b, c) __builtin_amdgcn_mfma_f32_32x32x16_bf16(a, b, c, 0, 0, 0)
#define ATT_VTR(p) __builtin_amdgcn_ds_read_tr16_b64_v4i16((LAS v4i16_t*)(p))

__device__ __forceinline__ void attn_unit(LAS unsigned char* lds, const bf16_t* PROJ, bf16_t* OCAT, const float* subg, float lam, float oml, int b, int h, int qb) {
    const int tid = opaque_tid(), lane = tid & 63, r32 = lane & 31, hi = lane >> 5, wid = __builtin_amdgcn_readfirstlane(tid >> 6), comp = wid >> 2, wq = wid & 3;
    const size_t rowbase = (size_t)b * SEQ; const int q0 = qb * 128;
    bf16x8 qr[4];
    { const bf16_t* qp = PROJ + (rowbase + q0 + wq * 32 + r32) * PP + h * 128 + comp * 64 + hi * 8;
#pragma unroll
      for (int d0 = 0; d0 < 4; ++d0) qr[d0] = *(const bf16x8*)(qp + d0 * 16); }
    constexpr int KSL = 18432, VB = 2 * KSL, VSL = 20480;
    const int krow = tid >> 3, kch = tid & 7, vrow0 = tid >> 4, vch = tid & 15;
    const bf16_t* kg = PROJ + (rowbase + krow) * PP + C_K + h * 128 + kch * 8;
    const bf16_t* vg = PROJ + (rowbase + vrow0) * PP + C_V + h * 128 + vch * 8;
    const int kst = krow * 144 + kch * 16, vst = VB + vrow0 * 320 + vch * 16;
    const int rot = qb * 2;
    u32x4 ga0, ga1, ga2, ga3;
#define ATT_LOAD(S, t) do { const size_t o_ = (size_t)(((t) + rot) & 31) * 64 * PP; g##S##0 = *(const u32x4*)(kg + o_); g##S##1 = *(const u32x4*)(kg + o_ + 64); g##S##2 = *(const u32x4*)(vg + o_); g##S##3 = *(const u32x4*)(vg + o_ + (size_t)32 * PP); } while (0)
#define ATT_STORE(S, ks, vs) do { *(LAS u32x4*)(lds + (ks) + kst) = g##S##0; *(LAS u32x4*)(lds + (ks) + 9216 + kst) = g##S##1; *(LAS u32x4*)(lds + (vs) + vst) = g##S##2; *(LAS u32x4*)(lds + (vs) + vst + 32 * 320) = g##S##3; } while (0)
    const int kread = comp * 9216 + r32 * 144 + hi * 16;
    const int vread = VB + (4 * hi + ((lane & 15) >> 2)) * 320 + ((lane >> 4) & 1) * 32 + (lane & 3) * 8;
    f32x16 o[4];
#pragma unroll
    for (int i = 0; i < 4; ++i)
#pragma unroll
        for (int r = 0; r < 16; ++r) o[i][r] = 0.f;
    float mrun, lrun = 0.f;
    f32x16 pA0, pA1, pB0, pB1, negm;
    const f32x16 zero16 = {0.f, 0.f, 0.f, 0.f, 0.f, 0.f, 0.f, 0.f, 0.f, 0.f, 0.f, 0.f, 0.f, 0.f, 0.f, 0.f};

    bf16x8 kf0, kf1, kf2, kf3, kf4, kf5, kf6, kf7;
#define ATT_KRD(ks) do { const LAS unsigned char* kb_ = lds + (ks) + kread; \
        kf0 = *(const LAS bf16x8*)(kb_); kf1 = *(const LAS bf16x8*)(kb_ + 32 * 144); kf2 = *(const LAS bf16x8*)(kb_ + 32); kf3 = *(const LAS bf16x8*)(kb_ + 32 * 144 + 32); \
        kf4 = *(const LAS bf16x8*)(kb_ + 64); kf5 = *(const LAS bf16x8*)(kb_ + 32 * 144 + 64); kf6 = *(const LAS bf16x8*)(kb_ + 96); kf7 = *(const LAS bf16x8*)(kb_ + 32 * 144 + 96); } while (0)
    ATT_LOAD(a, 0); ATT_STORE(a, 0, 0); ATT_LOAD(a, 1); __syncthreads();
    {
        ATT_KRD(0);
        pA0 = ATT_MFMA(kf0, qr[0], zero16); pA1 = ATT_MFMA(kf1, qr[0], zero16);
        pA0 = ATT_MFMA(kf2, qr[1], pA0); pA1 = ATT_MFMA(kf3, qr[1], pA1);
        pA0 = ATT_MFMA(kf4, qr[2], pA0); pA1 = ATT_MFMA(kf5, qr[2], pA1);
        pA0 = ATT_MFMA(kf6, qr[3], pA0); pA1 = ATT_MFMA(kf7, qr[3], pA1);
        float mx = fmaxf(pA0[0], pA1[0]);
#pragma unroll
        for (int r = 1; r < 16; ++r) mx = fmaxf(mx, fmaxf(pA0[r], pA1[r]));
        mrun = half_max(mx);
#pragma unroll
        for (int r = 0; r < 16; ++r) { pA0[r] = __builtin_amdgcn_exp2f(pA0[r] - mrun); pA1[r] = __builtin_amdgcn_exp2f(pA1[r] - mrun); negm[r] = -mrun; }
        asm volatile("" : "+v"(negm));
    }
    ATT_STORE(a, KSL, VSL); ATT_LOAD(a, 2); __syncthreads();
    ATT_KRD(KSL);
    int vs_prev = 0, vs_store = 2 * VSL;

#define ATT_PIN(x) asm volatile("" : "+v"(x))
#define ATT_GA(MF, A0, A1, A2, A3, W0, W1, PW) do { MF; sacc += A0; sacc2 += A1; sacc += A2; sacc2 += A3; ATT_PIN(sacc); ATT_PIN(sacc2); W0; W1; ATT_PIN(PW); ATT_SBAR(); } while (0)
#define ATT_VRD(dst, ms, dvb) do { const v4i16_t lo_ = ATT_VTR(vb_ + (ms) * 16 * 320 + (dvb) * 64), hh_ = ATT_VTR(vb_ + ((ms) * 16 + 8) * 320 + (dvb) * 64); \
        dst = (bf16x8){lo_[0], lo_[1], lo_[2], lo_[3], hh_[0], hh_[1], hh_[2], hh_[3]}; } while (0)
#define ATT_GB(ms, dvb, X, j, HASN, nms) do { \
        o[dvb] = ATT_MFMA(vf##dvb, __builtin_bit_cast(bf16x8, pw##ms), o[dvb]); \
        if (HASN) ATT_VRD(vf##dvb, nms, dvb); \
        X[j] = __builtin_amdgcn_exp2f(X[j]); X[(j) + 1] = __builtin_amdgcn_exp2f(X[(j) + 1]); ATT_PIN(X); \
        if (PROBE_EXP) { float d0_, d1_; asm volatile("v_exp_f32 %0, %2\n\tv_exp_f32 %1, %3" : "=&v"(d0_), "=&v"(d1_) : "v"(X[j]), "v"(X[(j) + 1])); } \
        ATT_SBAR(); } while (0)
#define ATT_STEP(C0, C1, P0, P1, t, MORE) do { \
        if (MORE) ATT_STORE(a, (((t) + 1) & 1) * KSL, vs_store);     \
        const LAS unsigned char* vb_ = lds + vs_prev + vread; \
        u32x4 pw0, pw1, pw2, pw3; float sacc = P0[0], sacc2 = P0[1]; bf16x8 vf0, vf1, vf2, vf3; \
        ATT_SBAR(); \
        ATT_GA(C0 = ATT_MFMA(kf0, qr[0], negm), P0[2], P0[3], P0[4], P0[5],     pw0.x = cvtpk_s(P0[0], P0[1]),   pw0.y = cvtpk_s(P0[2], P0[3]), pw0); \
        ATT_GA(C1 = ATT_MFMA(kf1, qr[0], negm), P0[6], P0[7], P0[8], P0[9],     pw0.z = cvtpk_s(P0[4], P0[5]),   pw0.w = cvtpk_s(P0[6], P0[7]), pw0); \
        ATT_GA(C0 = ATT_MFMA(kf2, qr[1], C0),     P0[10], P0[11], P0[12], P0[13], pw1.x = cvtpk_s(P0[8], P0[9]),   pw1.y = cvtpk_s(P0[10], P0[11]), pw1); \
        ATT_GA(C1 = ATT_MFMA(kf3, qr[1], C1),     P0[14], P0[15], P1[0], P1[1],   pw1.z = cvtpk_s(P0[12], P0[13]), pw1.w = cvtpk_s(P0[14], P0[15]), pw1); \
        ATT_VRD(vf0, 0, 0); ATT_GA(C0 = ATT_MFMA(kf4, qr[2], C0),     P1[2], P1[3], P1[4], P1[5],     pw2.x = cvtpk_s(P1[0], P1[1]),   pw2.y = cvtpk_s(P1[2], P1[3]), pw2); \
        ATT_VRD(vf1, 0, 1); ATT_GA(C1 = ATT_MFMA(kf5, qr[2], C1),     P1[6], P1[7], P1[8], P1[9],     pw2.z = cvtpk_s(P1[4], P1[5]),   pw2.w = cvtpk_s(P1[6], P1[7]), pw2); \
        ATT_VRD(vf2, 0, 2); ATT_GA(C0 = ATT_MFMA(kf6, qr[3], C0),     P1[10], P1[11], P1[12], P1[13], pw3.x = cvtpk_s(P1[8], P1[9]),   pw3.y = cvtpk_s(P1[10], P1[11]), pw3); \
        ATT_VRD(vf3, 0, 3); ATT_GA(C1 = ATT_MFMA(kf7, qr[3], C1),     P1[14], P1[15], 0.f, 0.f,       pw3.z = cvtpk_s(P1[12], P1[13]), pw3.w = cvtpk_s(P1[14], P1[15]), pw3); \
        lrun += sacc + sacc2; \
        asm volatile("s_nop 15\n\ts_nop 7" : "+v"(C0), "+v"(C1));     \
        float mxa_ = max3f(C0[0], C0[1], C1[0]), mxb_ = max3f(C0[2], C0[3], C1[1]); mxa_ = max3f(mxa_, C1[2], C1[3]); \
        _Pragma("unroll") for (int r = 4; r < 16; r += 4) { mxa_ = max3f(mxa_, C0[r], C0[r + 1]); mxb_ = max3f(mxb_, C0[r + 2], C0[r + 3]); mxa_ = max3f(mxa_, C1[r], C1[r + 1]); mxb_ = max3f(mxb_, C1[r + 2], C1[r + 3]); } \
        float mx_ = half_max(max2f(mxa_, mxb_)); \
        float f_ = 1.0f; \
        if (__builtin_expect(__any(mx_ > 8.0f), 0)) {     \
            const float dl_ = fmaxf(mx_, 0.f); mrun += dl_; f_ = __builtin_amdgcn_exp2f(-dl_); lrun *= f_; \
            _Pragma("unroll") for (int r = 0; r < 16; ++r) { C0[r] -= dl_; C1[r] -= dl_; negm[r] = -mrun; } \
            asm volatile("" : "+v"(negm)); } \
        ATT_SBAR(); \
        if (MORE) { asm volatile("s_waitcnt lgkmcnt(0)" ::: "memory"); __builtin_amdgcn_s_barrier(); asm volatile("" ::: "memory"); \
            ATT_LOAD(a, (t) + 2); ATT_KRD((((t) + 1) & 1) * KSL); } \
        ATT_SBAR(); \
        __builtin_amdgcn_s_setprio(1);     \
        ATT_GB(0, 0, C0, 0, true, 1);  ATT_GB(0, 1, C0, 2, true, 1);  ATT_GB(0, 2, C0, 4, true, 1);  ATT_GB(0, 3, C0, 6, true, 1); \
        ATT_GB(1, 0, C0, 8, true, 2);  ATT_GB(1, 1, C0, 10, true, 2); ATT_GB(1, 2, C0, 12, true, 2); ATT_GB(1, 3, C0, 14, true, 2); \
        ATT_GB(2, 0, C1, 0, true, 3);  ATT_GB(2, 1, C1, 2, true, 3);  ATT_GB(2, 2, C1, 4, true, 3);  ATT_GB(2, 3, C1, 6, true, 3); \
        ATT_GB(3, 0, C1, 8, false, 0); ATT_GB(3, 1, C1, 10, false, 0); ATT_GB(3, 2, C1, 12, false, 0); ATT_GB(3, 3, C1, 14, false, 0); \
        __builtin_amdgcn_s_setprio(0); \
        if (__any(f_ != 1.0f)) { \
            _Pragma("unroll") for (int i = 0; i < 4; ++i) _Pragma("unroll") for (int r = 0; r < 16; ++r) o[i][r] *= f_; } \
        vs_prev = (vs_prev == 3 * VSL) ? 0 : vs_prev + VSL; vs_store = (vs_store == 3 * VSL) ? 0 : vs_store + VSL; \
    } while (0)

    for (int t = 1; t < 31; t += 2) {
        ATT_STEP(pB0, pB1, pA0, pA1, t, true);
        ATT_STEP(pA0, pA1, pB0, pB1, t + 1, true);
    }
    ATT_STEP(pB0, pB1, pA0, pA1, 31, false);
    {
        float sacc = 0.f;
#pragma unroll
        for (int r = 0; r < 16; ++r) sacc += pB0[r] + pB1[r];
        lrun += sacc;
        u32x4 pw0, pw1, pw2, pw3;
        pw0.x = cvtpk_s(pB0[0], pB0[1]); pw0.y = cvtpk_s(pB0[2], pB0[3]); pw0.z = cvtpk_s(pB0[4], pB0[5]); pw0.w = cvtpk_s(pB0[6], pB0[7]);
        pw1.x = cvtpk_s(pB0[8], pB0[9]); pw1.y = cvtpk_s(pB0[10], pB0[11]); pw1.z = cvtpk_s(pB0[12], pB0[13]); pw1.w = cvtpk_s(pB0[14], pB0[15]);
        pw2.x = cvtpk_s(pB1[0], pB1[1]); pw2.y = cvtpk_s(pB1[2], pB1[3]); pw2.z = cvtpk_s(pB1[4], pB1[5]); pw2.w = cvtpk_s(pB1[6], pB1[7]);
        pw3.x = cvtpk_s(pB1[8], pB1[9]); pw3.y = cvtpk_s(pB1[10], pB1[11]); pw3.z = cvtpk_s(pB1[12], pB1[13]); pw3.w = cvtpk_s(pB1[14], pB1[15]);
        const LAS unsigned char* vb_ = lds + vs_prev + vread;
#define ATT_GD(ms, dvb) do { \
        const v4i16_t lo_ = ATT_VTR(vb_ + (ms) * 16 * 320 + (dvb) * 64), hh_ = ATT_VTR(vb_ + ((ms) * 16 + 8) * 320 + (dvb) * 64); \
        const bf16x8 vf_ = (bf16x8){lo_[0], lo_[1], lo_[2], lo_[3], hh_[0], hh_[1], hh_[2], hh_[3]}; \
        o[dvb] = ATT_MFMA(vf_, __builtin_bit_cast(bf16x8, pw##ms), o[dvb]); } while (0)
        ATT_GD(0, 0); ATT_GD(0, 1); ATT_GD(0, 2); ATT_GD(0, 3); ATT_GD(1, 0); ATT_GD(1, 1); ATT_GD(1, 2); ATT_GD(1, 3);
        ATT_GD(2, 0); ATT_GD(2, 1); ATT_GD(2, 2); ATT_GD(2, 3); ATT_GD(3, 0); ATT_GD(3, 1); ATT_GD(3, 2); ATT_GD(3, 3);
#undef ATT_GD
    }
    __syncthreads();
#undef ATT_LOAD
#undef ATT_STORE
#undef ATT_GA
#undef ATT_GB
#undef ATT_STEP
#undef ATT_KRD
#undef ATT_VRD
#undef ATT_PIN
    for (int rep_ = 0; rep_ <= PROBE_EPI; ++rep_) {
    {
        const float ltot = half_sum(lrun);
        float inv = 1.0f / ltot; if (comp == 1) inv *= lam;
        LAS float* cb = (LAS float*)lds + comp * (128 * 132) + (wq * 32 + r32) * 132 + 4 * hi;
#pragma unroll
        for (int dvb = 0; dvb < 4; ++dvb)
#pragma unroll
            for (int k4 = 0; k4 < 4; ++k4) {
                const f32x4 v = (f32x4){o[dvb][4 * k4 + 0] * inv, o[dvb][4 * k4 + 1] * inv, o[dvb][4 * k4 + 2] * inv, o[dvb][4 * k4 + 3] * inv};
                *(LAS f32x4*)(cb + dvb * 32 + 8 * k4) = v;
            }
    }
    __syncthreads();
    {
        const int q2 = tid >> 2, part = tid & 3;
        const LAS float* a0 = (const LAS float*)lds + q2 * 132 + part * 32; const LAS float* a1 = a0 + 128 * 132;
        f32x4 a[8]; float ss = 0.f;
#pragma unroll
        for (int i = 0; i < 8; ++i) { a[i] = *(const LAS f32x4*)(a0 + 4 * i) - *(const LAS f32x4*)(a1 + 4 * i); ss += (a[i].x * a[i].x + a[i].y * a[i].y) + (a[i].z * a[i].z + a[i].w * a[i].w); }
        ss += __shfl_xor(ss, 1); ss += __shfl_xor(ss, 2);
        const float rs = rsqrtf(ss * (1.0f / 128.0f) + EPS) * oml;
        const size_t row = rowbase + q0 + q2;
        const bf16_t* zp = PROJ + row * PP + C_ZA + h * 128 + part * 32; bf16_t* op = OCAT + row * 2048 + h * 128 + part * 32; const float* gp = subg + part * 32;
#pragma unroll
        for (int i = 0; i < 4; ++i) {
            const u32x4 z = *(const u32x4*)(zp + 8 * i); const f32x4 ga = *(const f32x4*)(gp + 8 * i), gb = *(const f32x4*)(gp + 8 * i + 4);
            const f32x4 xa = a[2 * i] * rs * ga, xb = a[2 * i + 1] * rs * gb;
            u32x4 w; w.x = cvt_pk_bf16(xa.x * silu_f(bflo(z.x)), xa.y * silu_f(bfhi(z.x))); w.y = cvt_pk_bf16(xa.z * silu_f(bflo(z.y)), xa.w * silu_f(bfhi(z.y)));
            w.z = cvt_pk_bf16(xb.x * silu_f(bflo(z.z)), xb.y * silu_f(bfhi(z.z))); w.w = cvt_pk_bf16(xb.z * silu_f(bflo(z.w)), xb.w * silu_f(bfhi(z.w)));
            *(u32x4*)(op + 8 * i) = w;
        }
    }
    __syncthreads();
    }
}

struct Args { const float* in[24]; float* out; unsigned char* ws; };
typedef const Args __attribute__((address_space(4)))* KArgsPtr;
__device__ __forceinline__ KArgsPtr kargs() { KArgsPtr p = (KArgsPtr)__builtin_amdgcn_kernarg_segment_ptr(); asm volatile("" : "+s"(p)); return p; }
#define WSP(T, off) ((T*)(ap->ws + (off)))

__global__ void __launch_bounds__(512, 2) fwd_megakernel(Args a_unused) {
    extern __shared__ __attribute__((aligned(16))) unsigned char lds_raw[];
    LAS unsigned char* lds = (LAS unsigned char*)lds_raw;
    cg::grid_group grid = cg::this_grid();
    const int G = gridDim.x, bx = blockIdx.x;
    const int NGW = G * 8;
#define PH_TID() const int tid = opaque_tid(), lane = tid & 63, wave = __builtin_amdgcn_readfirstlane(tid >> 6), gw = bx * 8 + wave; (void)lane; (void)gw; KArgsPtr ap = kargs()

#define XSYNC1() do { KArgsPtr ap_ = kargs(); XcdBarrier b_; b_.bar = (unsigned*)(ap_->ws + WS_BAR); b_.x = xb_xcc_id(); b_.st = (volatile LAS unsigned*)(lds + 139200); xcd_barrier(b_); } while (0)
#define GSYNC() do { XSYNC1(); if (PROBE_SYNC) XSYNC1(); } while (0)
    { if (threadIdx.x < 2) ((volatile LAS unsigned*)(lds + 139200))[threadIdx.x] = 0u; __syncthreads(); KArgsPtr ap_ = kargs(); xcd_barrier_post((unsigned*)(ap_->ws + WS_BAR)); }
    for (int r_ = 0; r_ <= (PROBE_P0 & 1); ++r_)
    { PH_TID();
      if (bx < 192) {
        LAS float* cond = (LAS float*)lds; const float* c_in = ap->in[1];
#pragma unroll 8
        for (int i = tid; i < 2048 * 8; i += 512) { const int b = i >> 11, k = i & 2047; cond[k * 8 + b] = silu_f(c_in[i]); }
        __syncthreads();
        for (int it = bx; it < 192; it += G) mod_item(it, ap->in[4], ap->in[5], WSP(float, WS_MOD), lds, tid);
      }
    }
    for (int r_ = 0; r_ <= ((PROBE_P0 >> 1) & 1); ++r_)
    { PH_TID();
      SsmIn sin_; sin_.a_re = ap->in[13]; sin_.a_im = ap->in[14]; sin_.log_dt = ap->in[15]; sin_.b_re = ap->in[16]; sin_.b_im = ap->in[17]; sin_.c_re = ap->in[18]; sin_.c_im = ap->in[19]; sin_.d_skip = ap->in[20];
      for (int it = (G - 1 - bx); it < 4 * NGRP; it += G) { const int l = it >> 7, g = (it >> 1) & 63;
          ssm_gen_item(l, g, it & 1, sin_, WSP(bf16_t, WS_WCAT) + l * WCAT_L, WSP(bf16_t, WS_WST) + l * WST_L, WSP(float, WS_LAMT) + l * LAMT_L, lds, tid); }
    }
    for (int r_ = 0; r_ <= ((PROBE_P0 >> 2) & 1); ++r_)
    { PH_TID();
        const float* w_in = ap->in[6]; const float* w_out = ap->in[7]; const float* w_glu = ap->in[21];
        bf16_t* WIN = WSP(bf16_t, WS_WIN); bf16_t* WOUT = WSP(bf16_t, WS_WOUT); bf16_t* WGLU = WSP(bf16_t, WS_WGLU);
        LAS float* scr = (LAS float*)(lds + wave * 16384);
        constexpr int I_IN = 32 * 192, I_OUT = 32 * 64, I_GLU = 16 * 64, NIT = 2 * (I_IN + I_OUT + I_GLU);
        for (int it = gw; it < NIT; it += NGW) {
            int r = it;
            if (r < 2 * I_IN) { const int l = r / I_IN, q = r % I_IN, kb = q / 192, nb = q % 192;
                transpose_item(w_in + (size_t)l * 2048 * 6144, 2048, 6144, WIN + (size_t)l * 6144 * 2048, kb * 64, nb * 32, nb * 32, scr, lane); continue; }
            r -= 2 * I_IN;
            if (r < 2 * I_OUT) { const int l = r / I_OUT, q = r % I_OUT, kb = q / 64, nb = q % 64;
                transpose_item(w_out + (size_t)l * 2048 * 2048, 2048, 2048, WOUT + (size_t)l * 2048 * 2048, kb * 64, nb * 32, nb * 32, scr, lane); continue; }
            r -= 2 * I_OUT;
            { const int l = r / I_GLU, q = r % I_GLU, kb = q / 64, nb = q % 64, n0 = nb * 32, bj = n0 >> 10, rem = n0 & 1023, pn = rem >> 7, jj = rem & 127;
              transpose_item(w_glu + (size_t)l * 1024 * 2048, 1024, 2048, WGLU + (size_t)l * 2048 * 1024, kb * 64, n0, pn * 256 + bj * 128 + jj, scr, lane); }
        }
    }
    for (int r_ = 0; r_ <= ((PROBE_P0 >> 3) & 1); ++r_)
    { PH_TID();
      const int* pos = (const int*)ap->in[2]; float* ROT = WSP(float, WS_ROT);
      for (int i = bx * 512 + tid; i < MTOK * 8; i += G * 512) {
        const int tok = i >> 3, j = i & 7;
        const float inv = exp2f(-(float)j * 0.125f * 18.931568569324174f);
        const float ang = (float)pos[tok] * inv; float s, c; sincosf(ang, &s, &c);
        ROT[(size_t)tok * 16 + j] = c; ROT[(size_t)tok * 16 + 8 + j] = s;
      }
      if (bx == 0 && wave < 2) {
        const float v1 = wave_sum(ap->in[8][wave * 64 + lane] * ap->in[9][wave * 64 + lane]), v2 = wave_sum(ap->in[10][wave * 64 + lane] * ap->in[11][wave * 64 + lane]);
        const float lam_init = 0.8f - 0.6f * expf(-0.3f * (float)wave);
        if (lane == 0) WSP(float, WS_LAMV)[wave] = expf(v1) - expf(v2) + lam_init;
      }
    }
    if (gridDim.y == 0x7fffu) grid.sync();
    GSYNC();
    { PH_TID(); norm_rows(ap->in[0], ap->in[3], WSP(float, WS_MOD), WSP(bf16_t, WS_H), nullptr, 0, gw, NGW, lane, (bf16_t*)ap->out); }
    GSYNC();

#pragma unroll 1
    for (int layer = 0; layer < 2; ++layer) {
        { KArgsPtr ap = kargs();
          pg8::StaticOrder S; S.init(MTOK, DIN, G, bx, WSP(bf16_t, WS_H), WSP(bf16_t, WS_WIN) + (size_t)layer * 6144 * 2048, DM, DM);
          EpiInProj E{ap->ws};
          for (int rep = 0; rep <= PROBE_INPROJ; ++rep) pg8::gemm_phase<INPROJ_SP2>(lds, DM, DM, DM, S, E); }
        GSYNC();
        { KArgsPtr ap = kargs();
          const int vcu = (G % 8 == 0) ? (bx % 8) * (G / 8) + bx / 8 : bx;
          pg8::GroupOrder S; S.init(NGRP, 2, 1, G, vcu, WSP(bf16_t, WS_ACOMB), WSP(bf16_t, WS_WST) + layer * WST_L, KA, 512, (size_t)RG * KA * 2, (size_t)256 * 512 * 2);
          EpiS1 E{WSP(float, WS_SBUF)};
          pg8::gemm_phase(lds, 512, KA, 512, S, E);
          if (PROBE_SSM & 1) pg8::gemm_phase(lds, 512, KA, 512, S, E); }
        GSYNC();
        for (int rep = 0; rep <= ((PROBE_SSM >> 1) & 1); ++rep) { PH_TID(); s2_phase(WSP(float, WS_SBUF), WSP(bf16_t, WS_ACOMB), WSP(float, WS_LAMT) + layer * LAMT_L, bx, tid); }
        { KArgsPtr ap = kargs();
          const int vcu = (G % 8 == 0) ? (bx % 8) * (G / 8) + bx / 8 : bx;
          const float lam = WSP(float, WS_LAMV)[layer], lam_init = 0.8f - 0.6f * expf(-0.3f * (float)layer);
          const bf16_t* PROJ = WSP(bf16_t, WS_PROJ); bf16_t* OCAT = WSP(bf16_t, WS_H); const float* subg = ap->in[12] + layer * 128;
          for (int rep = 0; rep <= PROBE_ATT; ++rep)
          for (int un = vcu; un < NB * NHEAD * 16; un += G) { const int bh = un >> 4, qb = un & 15; attn_unit(lds, PROJ, OCAT, subg, lam, 1.0f - lam_init, bh >> 3, bh & 7, qb); } }
        GSYNC();
        { KArgsPtr ap = kargs();
          const int vcu = (G % 8 == 0) ? (bx % 8) * (G / 8) + bx / 8 : bx;
          pg8::GroupOrder S; S.init(NGRP, 2, 2, G, vcu, WSP(bf16_t, WS_ACOMB), WSP(bf16_t, WS_WCAT) + layer * WCAT_L, KA, KA, (size_t)RG * KA * 2, (size_t)512 * KA * 2);
          EpiS3 E{WSP(bf16_t, WS_YG)};
          pg8::gemm_phase(lds, KA, KA, KA, S, E);
          if (PROBE_SSM & 4) pg8::gemm_phase(lds, KA, KA, KA, S, E); }
        GSYNC();
        { KArgsPtr ap = kargs();
          pg8::StaticOrder S; S.init(MTOK, 2048, G, bx, WSP(bf16_t, WS_YG), WSP(bf16_t, WS_WGLU) + (size_t)layer * 2048 * 1024, 1024, 1024);
          EpiGLU E{ap->ws, ap->in[22] + layer * 2048};
          for (int rep = 0; rep <= PROBE_GLU; ++rep) pg8::gemm_phase(lds, 1024, 1024, 1024, S, E); }
        GSYNC();
        { KArgsPtr ap = kargs();
          pg8::PanelOrder S; S.init(bx, WSP(bf16_t, WS_H), WSP(bf16_t, WS_WOUT) + (size_t)layer * 2048 * 2048, DM, DM);
          EpiOutNorm E{ap->out, WSP(float, WS_MOD) + (size_t)layer * 8 * 6144 + 4096, WSP(float, WS_RSS) + layer * 16384, WSP(unsigned, WS_CNT) + layer * 64 * 64,
                       layer == 0 ? ap->in[3] + DM : ap->in[23], WSP(float, WS_MOD) + (size_t)8 * 6144, WSP(bf16_t, WS_H), layer, ap->ws};
          pg8::gemm_phase(lds, DM, DM, DM, S, E); }
        if (layer == 0) GSYNC();
    }
}

extern "C" void kernel_launch(void* const* d_in, const int* in_sizes, int n_in, void* d_out, int out_size, void* d_ws, size_t ws_size, hipStream_t stream) {
    static int grid = 0;
    if (grid == 0) {
        if (n_in != 24 || out_size != MTOK * DM || ws_size < WS_END) { fprintf(stderr, "kernel_launch: unexpected shapes (n_in %d out %d ws %zu)\n", n_in, out_size, ws_size); grid = -1; return; }
        int dev = 0, cus = 0, per_cu = 0;
        (void)hipGetDevice(&dev);
        (void)hipDeviceGetAttribute(&cus, hipDeviceAttributeMultiprocessorCount, dev);
        (void)hipFuncSetAttribute((const void*)fwd_megakernel, hipFuncAttributeMaxDynamicSharedMemorySize, LDS_BYTES);
        (void)hipOccupancyMaxActiveBlocksPerMultiprocessor(&per_cu, (const void*)fwd_megakernel, 512, LDS_BYTES);
        if (per_cu < 1) { fprintf(stderr, "kernel_launch: occupancy query says %d blocks per CU\n", per_cu); per_cu = 1; }
        if (cus != 256) { fprintf(stderr, "kernel_launch: built for 256 CUs (got %d)\n", cus); grid = -1; return; }
        grid = cus;
    }
    if (grid < 0) return;
    (void)hipMemsetAsync((char*)d_ws + WS_BAR, 0, CTL_BYTES, stream);
    Args a{};
    for (int i = 0; i < 24; ++i) a.in[i] = (const float*)d_in[i];
    a.out = (float*)d_out; a.ws = (unsigned char*)d_ws;
    void* args[] = {&a};
    hipError_t e = hipLaunchCooperativeKernel((void*)fwd_megakernel, dim3(grid), dim3(512), args, LDS_BYTES, stream);
    if (e != hipSuccess) fprintf(stderr, "cooperative launch failed: %s (grid %d)\n", hipGetErrorString(e), grid);
}
```
